# Optimizing an MI355X kernel written in HIP

```python
import jax, jax.numpy as jnp
from jax import lax
import numpy as np

D_MODEL = 4096
BATCH = 1
SEQ = 16384
DEPTH = 4

GRID_W = 64
CTX_LEN = 256
EPS = 1e-6
ADA_RANK = 256
N_MOD = 9
D_FF = D_MODEL
D_SSD = D_MODEL // 2
SSD_HEAD_DIM = 64
SSD_HEADS = D_SSD // SSD_HEAD_DIM
SSD_GROUPS = 4
HEADS_PER_GROUP = SSD_HEADS // SSD_GROUPS
D_STATE = 128
D_CONV = 5
SSD_CHUNK = 128
C_XBC = D_SSD + 2 * SSD_GROUPS * D_STATE
D_MLP = D_MODEL // 4
MLP_CHUNK = 128
MLP_GROUP_DIM = 128
MLP_GROUPS = D_MLP // MLP_GROUP_DIM
D_FFT = D_MODEL // 4
FFT_GROUP_DIM = 128
FFT_GROUPS = D_FFT // FFT_GROUP_DIM
N_BRANCH = 3
OFF_Z = 0
OFF_XBC = OFF_Z + D_SSD
OFF_DT = OFF_XBC + C_XBC
OFF_U = OFF_DT + 2 * SSD_HEADS
OFF_V = OFF_U + D_MLP
OFF_F = OFF_V + D_MLP
OFF_GATE = OFF_F + D_FFT
D_IN = OFF_GATE + N_BRANCH * D_MODEL

kernel_name = "hybrid_ssd_sgu_fourier_dit_trunk"


def rmsnorm(x, g):
    xf = x.astype(jnp.float32)
    y = xf * lax.rsqrt(jnp.mean(xf * xf, axis=-1, keepdims=True) + EPS)
    return (y * g.astype(jnp.float32)).astype(x.dtype)


def adaln_mod(cvec, w1, w2, b):
    m = (jax.nn.silu(cvec) @ w1) @ w2 + b
    return jnp.split(m, N_MOD, axis=-1)


def modulate(h, shift, scale):
    return h * (1.0 + scale[:, None, :]) + shift[:, None, :]


def swiglu(h, w1, w3, w2):
    return (jax.nn.silu(h @ w1) * (h @ w3)) @ w2


def dwconv_rows(u, rows, width, w, bias):
    b, l, ch = u.shape
    half = D_CONV // 2
    up = jnp.pad(u.reshape(b, rows, width, ch), ((0, 0), (0, 0), (half, half), (0, 0)))
    y = bias
    for k in range(D_CONV):
        y = y + up[:, :, k:k + width] * w[k]
    return y.reshape(b, l, ch)


def segsum(a):
    t = a.shape[-1]
    rep = jnp.broadcast_to(a[..., :, None], a.shape + (t,))
    strict = jnp.tril(jnp.ones((t, t), dtype=bool), -1)
    cs = jnp.cumsum(jnp.where(strict, rep, 0.0), axis=-2)
    return jnp.where(jnp.tril(jnp.ones((t, t), dtype=bool)), cs, -jnp.inf)


def ssd_scan(xs, dt, A, bm, cm, init_state):
    f32 = jnp.float32
    b, l, g, r, p = xs.shape
    nc = l // SSD_CHUNK
    a = (dt * A).astype(f32)
    xc = (xs * dt[..., None]).astype(f32).reshape(b, nc, SSD_CHUNK, g, r, p)
    bc = bm.astype(f32).reshape(b, nc, SSD_CHUNK, g, D_STATE)
    cc = cm.astype(f32).reshape(b, nc, SSD_CHUNK, g, D_STATE)
    ac = a.reshape(b, nc, SSD_CHUNK, g, r).transpose(0, 3, 4, 1, 2)
    a_cs = jnp.cumsum(ac, axis=-1)
    decay_in = jnp.exp(segsum(ac))
    cb = jnp.einsum("bcqgn,bcsgn->bgcqs", cc, bc)
    y_diag = jnp.einsum("bgrcqs,bcsgrp->bcqgrp", cb[:, :, None] * decay_in, xc)
    decay_to_end = jnp.exp(a_cs[..., -1:] - a_cs)
    states = jnp.einsum("bcsgn,bgrcs,bcsgrp->bcgrpn", bc, decay_to_end, xc)
    states = jnp.concatenate([init_state.astype(f32)[:, None], states], axis=1)
    chunk_a = jnp.pad(a_cs[..., -1], ((0, 0), (0, 0), (0, 0), (1, 0)))
    chunk_decay = jnp.exp(segsum(chunk_a))
    new_states = jnp.einsum("bgrzc,bcgrpn->bzgrpn", chunk_decay, states)
    y_off = jnp.einsum("bcqgn,bcgrpn,bgrcq->bcqgrp", cc, new_states[:, :-1], jnp.exp(a_cs))
    y = (y_diag + y_off).reshape(b, l, g, r, p)
    return y.astype(xs.dtype), new_states[:, -1]


def ssd_mixer(proj, rows, width, init_states, conv_w, conv_b, a_log, dt_bias, d_skip, norm_g):
    b, l, _ = proj.shape
    z = proj[..., OFF_Z:OFF_Z + D_SSD]
    xbc = jax.nn.silu(dwconv_rows(proj[..., OFF_XBC:OFF_XBC + C_XBC], rows, width, conv_w, conv_b))
    dt_raw = proj[..., OFF_DT:OFF_DT + 2 * SSD_HEADS]
    xs = xbc[..., :D_SSD].reshape(b, l, SSD_GROUPS, HEADS_PER_GROUP, SSD_HEAD_DIM)
    bm = xbc[..., D_SSD:D_SSD + SSD_GROUPS * D_STATE].reshape(b, l, SSD_GROUPS, D_STATE)
    cm = xbc[..., D_SSD + SSD_GROUPS * D_STATE:].reshape(b, l, SSD_GROUPS, D_STATE)
    dt = jax.nn.softplus(dt_raw.reshape(b, l, 2, SSD_GROUPS, HEADS_PER_GROUP)
                         + dt_bias.reshape(2, SSD_GROUPS, HEADS_PER_GROUP))
    A = -jnp.exp(a_log.astype(jnp.float32)).reshape(2, SSD_GROUPS, HEADS_PER_GROUP)
    init_f, init_b = init_states
    y_f, s_f = ssd_scan(xs, dt[:, :, 0], A[0], bm, cm, init_f)
    flip = lambda t: jnp.flip(t, axis=1)
    y_b, s_b = ssd_scan(flip(xs), flip(dt[:, :, 1]), A[1], flip(bm), flip(cm), init_b)
    y = y_f + flip(y_b) + d_skip.reshape(SSD_GROUPS, HEADS_PER_GROUP)[:, :, None] * xs
    y = y.reshape(b, l, D_SSD) * jax.nn.silu(z)
    y = rmsnorm(y.reshape(b, l, SSD_GROUPS, D_SSD // SSD_GROUPS), norm_g.reshape(SSD_GROUPS, -1))
    return y.reshape(b, l, D_SSD), (s_f, s_b)


def chunk_sgu(u, v, norm_g, w_s, b_s):
    b, l, _ = u.shape
    nc = l // MLP_CHUNK
    u = jax.nn.gelu(u).reshape(b, nc, MLP_CHUNK, MLP_GROUPS, MLP_GROUP_DIM)
    v = rmsnorm(jax.nn.gelu(v), norm_g).reshape(b, nc, MLP_CHUNK, MLP_GROUPS, MLP_GROUP_DIM)
    vm = jnp.einsum("gqs,bnsgc->bnqgc", w_s, v) + b_s.T[:, :, None]
    return (u * vm).reshape(b, l, D_MLP)


def fourier_mix(f):
    b, l, _ = f.shape
    fg = f.astype(jnp.float32).reshape(b, l, FFT_GROUPS, FFT_GROUP_DIM)
    out = jnp.fft.fft2(fg, axes=(1, 3), norm="ortho").real
    return out.astype(f.dtype).reshape(b, l, D_FFT)


def parallel_merge(proj, y_ssd, sgu_norm, sgu_w, sgu_b, w_br_ssd, w_br_mlp, w_br_fft, w_out):
    y_mlp = chunk_sgu(proj[..., OFF_U:OFF_U + D_MLP], proj[..., OFF_V:OFF_V + D_MLP], sgu_norm, sgu_w, sgu_b)
    y_fft = fourier_mix(proj[..., OFF_F:OFF_F + D_FFT])
    g_ssd, g_mlp, g_fft = jnp.split(jax.nn.sigmoid(proj[..., OFF_GATE:]), N_BRANCH, axis=-1)
    merged = g_ssd * (y_ssd @ w_br_ssd) + g_mlp * (y_mlp @ w_br_mlp) + g_fft * (y_fft @ w_br_fft)
    return merged @ w_out


def setup_inputs(seed: int = 0) -> dict:
    key = jax.random.key(seed)
    ks = jax.random.split(key, 40)
    L = DEPTH

    def nrm(i, shape, scale):
        return jax.random.normal(ks[i], shape, jnp.float32) * scale

    def gain(i, shape):
        return 1.0 + nrm(i, shape, 0.02)

    dt0 = jnp.exp(jax.random.uniform(ks[20], (L, 2, SSD_HEADS), jnp.float32,
                                     minval=float(np.log(1e-3)), maxval=float(np.log(1e-1))))
    return {
        "x": nrm(0, (BATCH, SEQ, D_MODEL), 1.0),
        "c": nrm(1, (BATCH, D_MODEL), 1.0),
        "ctx": nrm(2, (BATCH, CTX_LEN, D_MODEL), 1.0),
        "c_ctx": nrm(3, (D_MODEL,), 1.0),
        "ada_w1": nrm(4, (L, D_MODEL, ADA_RANK), D_MODEL ** -0.5),
        "ada_w2": nrm(5, (L, ADA_RANK, N_MOD * D_MODEL), 0.5 * ADA_RANK ** -0.5),
        "ada_b": nrm(6, (L, N_MOD * D_MODEL), 0.02),
        "norm_ffn1": gain(7, (L, D_MODEL)),
        "f1_w1": nrm(8, (L, D_MODEL, D_FF), D_MODEL ** -0.5),
        "f1_w3": nrm(9, (L, D_MODEL, D_FF), D_MODEL ** -0.5),
        "f1_w2": nrm(10, (L, D_FF, D_MODEL), D_FF ** -0.5),
        "norm_mix": gain(11, (L, D_MODEL)),
        "w_in": nrm(12, (L, D_MODEL, D_IN), D_MODEL ** -0.5),
        "b_in": nrm(13, (L, D_IN), 0.02),
        "conv_w": nrm(14, (L, D_CONV, C_XBC), D_CONV ** -0.5),
        "conv_b": nrm(15, (L, C_XBC), 0.02),
        "a_log": jnp.log(jax.random.uniform(ks[16], (L, 2, SSD_HEADS), jnp.float32, minval=1.0, maxval=16.0)),
        "dt_bias": dt0 + jnp.log(-jnp.expm1(-dt0)),
        "d_skip": gain(17, (L, SSD_HEADS)),
        "norm_ssd": gain(18, (L, D_SSD)),
        "sgu_norm": gain(19, (L, D_MLP)),
        "sgu_w": nrm(21, (L, MLP_GROUPS, MLP_CHUNK, MLP_CHUNK), 0.5 * MLP_CHUNK ** -0.5),
        "sgu_b": gain(22, (L, MLP_GROUPS, MLP_CHUNK)),
        "w_br_ssd": nrm(23, (L, D_SSD, D_MODEL), D_SSD ** -0.5),
        "w_br_mlp": nrm(24, (L, D_MLP, D_MODEL), D_MLP ** -0.5),
        "w_br_fft": nrm(25, (L, D_FFT, D_MODEL), D_FFT ** -0.5),
        "w_out": nrm(26, (L, D_MODEL, D_MODEL), D_MODEL ** -0.5),
        "norm_ffn2": gain(27, (L, D_MODEL)),
        "f2_w1": nrm(28, (L, D_MODEL, D_FF), D_MODEL ** -0.5),
        "f2_w3": nrm(29, (L, D_MODEL, D_FF), D_MODEL ** -0.5),
        "f2_w2": nrm(30, (L, D_FF, D_MODEL), D_FF ** -0.5),
        "norm_final": gain(31, (D_MODEL,)),
    }


def reference(x, c, ctx, c_ctx, ada_w1, ada_w2, ada_b, norm_ffn1, f1_w1, f1_w3, f1_w2, norm_mix, w_in, b_in,
              conv_w, conv_b, a_log, dt_bias, d_skip, norm_ssd, sgu_norm, sgu_w, sgu_b,
              w_br_ssd, w_br_mlp, w_br_fft, w_out, norm_ffn2, f2_w1, f2_w3, f2_w2, norm_final):
    b = x.shape[0]
    rows = x.shape[1] // GRID_W
    ctx_len = ctx.shape[1]
    cc = c_ctx[None, :]
    zero_state = jnp.zeros((b, SSD_GROUPS, HEADS_PER_GROUP, SSD_HEAD_DIM, D_STATE), jnp.float32)
    for i in range(DEPTH):
        last = i == DEPTH - 1
        sh1, sc1, g1, shm, scm, gm, sh2, sc2, g2 = adaln_mod(c, ada_w1[i], ada_w2[i], ada_b[i])
        csh1, csc1, cg1, cshm, cscm, cgm, csh2, csc2, cg2 = adaln_mod(cc, ada_w1[i], ada_w2[i], ada_b[i])
        x = x + 0.5 * g1[:, None] * swiglu(modulate(rmsnorm(x, norm_ffn1[i]), sh1, sc1), f1_w1[i], f1_w3[i], f1_w2[i])
        ctx = ctx + 0.5 * cg1[:, None] * swiglu(modulate(rmsnorm(ctx, norm_ffn1[i]), csh1, csc1),
                                                f1_w1[i], f1_w3[i], f1_w2[i])
        px = modulate(rmsnorm(x, norm_mix[i]), shm, scm) @ w_in[i] + b_in[i]
        pc = modulate(rmsnorm(ctx, norm_mix[i]), cshm, cscm) @ w_in[i] + b_in[i]
        ssd_params = (conv_w[i], conv_b[i], a_log[i], dt_bias[i], d_skip[i], norm_ssd[i])
        y_ssd_c, ctx_states = ssd_mixer(pc, 1, ctx_len, (zero_state, zero_state), *ssd_params)
        y_ssd_x, _ = ssd_mixer(px, rows, GRID_W, ctx_states, *ssd_params)
        merge_params = (sgu_norm[i], sgu_w[i], sgu_b[i], w_br_ssd[i], w_br_mlp[i], w_br_fft[i], w_out[i])
        x = x + gm[:, None] * parallel_merge(px, y_ssd_x, *merge_params)
        if not last:
            ctx = ctx + cgm[:, None] * parallel_merge(pc, y_ssd_c, *merge_params)
            ctx = ctx + 0.5 * cg2[:, None] * swiglu(modulate(rmsnorm(ctx, norm_ffn2[i]), csh2, csc2),
                                                    f2_w1[i], f2_w3[i], f2_w2[i])
        x = x + 0.5 * g2[:, None] * swiglu(modulate(rmsnorm(x, norm_ffn2[i]), sh2, sc2), f2_w1[i], f2_w3[i], f2_w2[i])
    return rmsnorm(x, norm_final)
```

```cpp
#include <hip/hip_runtime.h>
#include <cstdio>
#include <cstdint>

#ifndef MK_SPLIT
#define MK_SPLIT 0
#endif

namespace pg8 {
#define PG8_LAS __attribute__((address_space(3)))
typedef unsigned short bf16_t;
typedef short bf16x8 __attribute__((ext_vector_type(8)));
typedef float f32x4 __attribute__((ext_vector_type(4)));
typedef unsigned u32x4 __attribute__((ext_vector_type(4)));
constexpr int BM = 256, BK = 64, HALF = 128, HTB = HALF * BK * 2  , STAGE_BYTES = 8 * HTB, NXCD = 8, WGM = 8;

__host__ __device__ __forceinline__ int lds_byte(int r, int c) { const int st = (r >> 4) * 2 + (c >> 5), rr = r & 15, cc = c & 31, ob = rr * 64 + cc * 2; return st * 1024 + (ob ^ (((ob >> 9) & 1) << 5)); }
__host__ __device__ __forceinline__ void stage_rc(int b, int& R, int& C) { const int st = b / 1024, sb = b % 1024, swz = sb ^ (((sb >> 9) & 1) << 5); R = (st >> 1) * 16 + swz / 64; C = (st & 1) * 32 + (swz % 64) / 2; }
__host__ __device__ __forceinline__ int perm32(int rho) { const int n = rho >> 4, i = rho & 15; return 8 * (i >> 2) + 4 * n + (i & 3); }

struct Unit { int pm, pn; };
struct Gemm { const bf16_t* A; const bf16_t* Bt; int M, N, K; int ld = 0; };

struct StaticOrder {
    int nM, nN, nwg, G, c;
    __host__ __device__ void init(int M, int N, int G_, int c_) { nM = M / BM; nN = N / BM; nwg = nM * nN; G = G_; c = c_; }
    __host__ __device__ bool next(int i, Unit& u) const {
        const long L = (long)i * G + c; if (L >= nwg) return false;
        int wgid = (int)L; { const int q = nwg / NXCD, r = nwg % NXCD, xcd = wgid % NXCD, off = wgid / NXCD; wgid = (xcd < r ? xcd * (q + 1) : r * (q + 1) + (xcd - r) * q) + off; }
        const int nig = WGM * nN, gid = wgid / nig, fm = gid * WGM, gsz = (nM - fm) < WGM ? (nM - fm) : WGM;
        u.pm = fm + ((wgid % nig) % gsz); u.pn = (wgid % nig) / gsz; return true;
    }
    __device__ __forceinline__ void a_ready(const Unit&) const {}
    __device__ __forceinline__ void done(const Unit&) const {}
};
template <class Epi, class Sched, bool ALIGN_EPI = false, bool SP2 = false>
__device__ __forceinline__ void gemm_phase(PG8_LAS unsigned char* lds, const Gemm g, const Sched& S, const Epi& E) {
    int tid_ = threadIdx.x; asm volatile("" : "+v"(tid_));   const int tid = tid_, wid = __builtin_amdgcn_readfirstlane(tid >> 6), lane = tid & 63, wr = wid >> 2, wc = wid & 3, fr = lane & 15, fq = lane >> 4;
    const int K = g.K, nt = K / BK, LD = g.ld ? g.ld : g.K;
    unsigned voffA[2], voffB[2];
#pragma unroll
    for (int i = 0; i < 2; ++i) { int R, C; stage_rc(tid * 16 + i * 8192, R, C); const int Rb = Epi::PERM ? ((R & ~31) + perm32(R & 31)) : R;
        voffA[i] = (unsigned)(R * LD + C) * 2u; voffB[i] = (unsigned)(Rb * LD + C) * 2u; }
    const size_t kstep = (size_t)(BK * 2);
    const size_t hstep = (size_t)HALF * LD * 2;
    const size_t tstep = 2 * hstep;
    const unsigned ldsw = (unsigned)wid * 1024u;
    const int aoff = lds_byte(wr * 64 + fr, fq * 8), boff = lds_byte(wc * 32 + fr, fq * 8);
#define PG8_SA(b, h) (((b) * 2 + (h)) * HTB)
#define PG8_SB(b, h) ((4 + (b) * 2 + (h)) * HTB)
#define PG8_STAGE(bufoff, gbase, voff) do { _Pragma("unroll") for (int _i = 0; _i < 2; ++_i) \
        __builtin_amdgcn_global_load_lds((const unsigned*)((const char*)(gbase) + (voff)[_i]), (PG8_LAS unsigned*)(lds + (bufoff) + ldsw + _i * 8192), 16, 0, 0); } while (0)
#define PG8_LDA(dst, b, h) do { _Pragma("unroll") for (int m = 0; m < 4; ++m) _Pragma("unroll") for (int k = 0; k < 2; ++k) dst[m][k] = *(const PG8_LAS bf16x8*)(lds + PG8_SA(b, h) + aoff + m * 2048 + k * 1024); } while (0)
#define PG8_LDB(dst, b, h) do { _Pragma("unroll") for (int n = 0; n < 2; ++n) _Pragma("unroll") for (int k = 0; k < 2; ++k) dst[n][k] = *(const PG8_LAS bf16x8*)(lds + PG8_SB(b, h) + boff + n * 2048 + k * 1024); } while (0)
#define PG8_MMA(ai, bj, At, Bt) do { __builtin_amdgcn_s_setprio(1); _Pragma("unroll") for (int m = 0; m < 4; ++m) _Pragma("unroll") for (int n = 0; n < 2; ++n) _Pragma("unroll") for (int k = 0; k < 2; ++k) \
        acc[ai][bj][m][n] = __builtin_amdgcn_mfma_f32_16x16x32_bf16(Bt[n][k], At[m][k], acc[ai][bj][m][n], 0, 0, 0); __builtin_amdgcn_s_setprio(0); } while (0)
#define PG8_WAIT_V(n) asm volatile("s_waitcnt vmcnt(" #n ")" ::: "memory")
#define PG8_WAIT_L(n) asm volatile("s_waitcnt lgkmcnt(" #n ")" ::: "memory")
#define PG8_BAR __builtin_amdgcn_s_barrier()
#define PG8_SCHED __builtin_amdgcn_sched_barrier(0)
    Unit cur, nxt; int ui = 0;
    if (!S.next(0, cur)) return;
    f32x4 acc[2][2][4][2];
#pragma unroll
    for (int a = 0; a < 2; ++a)
#pragma unroll
        for (int b = 0; b < 2; ++b)
#pragma unroll
            for (int m = 0; m < 4; ++m)
#pragma unroll
                for (int n = 0; n < 2; ++n) acc[a][b][m][n] = (f32x4){0.f, 0.f, 0.f, 0.f};
    bf16x8 At[4][2], B0[2][2], B1[2][2];
    typename Epi::Pre pre; E.pre_init(pre);
    const char* cA = (const char*)g.A + (size_t)cur.pm * tstep; const char* cB = (const char*)g.Bt + (size_t)cur.pn * tstep;
    S.a_ready(cur);
    if constexpr (SP2) {
        PG8_STAGE(PG8_SB(0, 0), cB, voffB); PG8_STAGE(PG8_SB(0, 1), cB + hstep, voffB); PG8_STAGE(PG8_SA(0, 0), cA, voffA); PG8_STAGE(PG8_SA(0, 1), cA + hstep, voffA);
        if (wr == 1) PG8_BAR;
        PG8_WAIT_V(2); PG8_BAR;
        PG8_STAGE(PG8_SB(1, 0), cB + kstep, voffB); PG8_STAGE(PG8_SA(1, 0), cA + kstep, voffA); PG8_STAGE(PG8_SB(1, 1), cB + hstep + kstep, voffB);
        PG8_WAIT_V(6); PG8_BAR;
    } else {
        PG8_STAGE(PG8_SB(0, 0), cB, voffB); PG8_STAGE(PG8_SA(0, 0), cA, voffA); PG8_STAGE(PG8_SB(0, 1), cB + hstep, voffB); PG8_STAGE(PG8_SA(0, 1), cA + hstep, voffA);
        if (wr == 1) PG8_BAR;
        PG8_WAIT_V(4); PG8_BAR;
        PG8_STAGE(PG8_SB(1, 0), cB + kstep, voffB); PG8_STAGE(PG8_SA(1, 0), cA + kstep, voffA); PG8_STAGE(PG8_SB(1, 1), cB + hstep + kstep, voffB);
        PG8_WAIT_V(6); PG8_BAR;
    }
    for (;;) {
        const bool has_next = S.next(ui + 1, nxt);
        const char* nA = has_next ? (const char*)g.A + (size_t)nxt.pm * tstep : cA; const char* nB = has_next ? (const char*)g.Bt + (size_t)nxt.pn * tstep : cB;
        for (int t = 0; t < nt; t += 2) {
            const bool last = (t == nt - 2);
            const char* a1 = cA + (size_t)(t + 1) * kstep;
            const char* a2 = last ? nA : cA + (size_t)(t + 2) * kstep; const char* b2 = last ? nB : cB + (size_t)(t + 2) * kstep;
            const char* a3 = a2 + kstep; const char* b3 = b2 + kstep;
            if (last && has_next) S.a_ready(nxt);
            if (last) E.prefetch(pre, cur, wr, wc, fr, fq);
            if constexpr (Epi::KHOOK) { if (t == Epi::H1 || t == Epi::H2) E.khook(acc, cur, t, wr, wc, fr, fq); }
            if constexpr (SP2) {
            PG8_LDB(B0, 0, 0); PG8_LDB(B1, 0, 1); PG8_SCHED; PG8_LDA(At, 0, 0); PG8_STAGE(PG8_SA(1, 1), a1 + hstep, voffA);
            PG8_WAIT_V(8); PG8_WAIT_L(0); PG8_BAR; PG8_MMA(0, 0, At, B0); PG8_MMA(0, 1, At, B1); PG8_BAR; PG8_SCHED;
            PG8_LDA(At, 0, 1); PG8_STAGE(PG8_SB(0, 0), b2, voffB); PG8_STAGE(PG8_SB(0, 1), b2 + hstep, voffB); PG8_STAGE(PG8_SA(0, 0), a2, voffA);
            PG8_WAIT_V(8); PG8_WAIT_L(0); PG8_BAR; PG8_MMA(1, 0, At, B0); PG8_MMA(1, 1, At, B1); PG8_BAR; PG8_SCHED;
            PG8_LDB(B0, 1, 0); PG8_LDB(B1, 1, 1); PG8_SCHED; PG8_LDA(At, 1, 0); PG8_STAGE(PG8_SA(0, 1), a2 + hstep, voffA);
            PG8_WAIT_V(8); PG8_WAIT_L(0); PG8_BAR; PG8_MMA(0, 0, At, B0); PG8_MMA(0, 1, At, B1); PG8_BAR; PG8_SCHED;
            PG8_LDA(At, 1, 1); PG8_STAGE(PG8_SB(1, 0), b3, voffB); PG8_STAGE(PG8_SB(1, 1), b3 + hstep, voffB); PG8_STAGE(PG8_SA(1, 0), a3, voffA);
            PG8_WAIT_V(8); PG8_WAIT_L(0); PG8_BAR; PG8_MMA(1, 0, At, B0); PG8_MMA(1, 1, At, B1); PG8_BAR; PG8_SCHED;
            } else {
            PG8_LDB(B0, 0, 0); PG8_SCHED; PG8_LDA(At, 0, 0); PG8_STAGE(PG8_SA(1, 1), a1 + hstep, voffA);
            PG8_WAIT_L(8); PG8_BAR; PG8_WAIT_L(0); PG8_MMA(0, 0, At, B0); PG8_BAR; PG8_SCHED;
            PG8_LDB(B1, 0, 1); PG8_STAGE(PG8_SB(0, 0), b2, voffB);
            PG8_BAR; PG8_WAIT_L(0); PG8_MMA(0, 1, At, B1); PG8_BAR;
            PG8_LDA(At, 0, 1); PG8_STAGE(PG8_SA(0, 0), a2, voffA);
            PG8_BAR; PG8_WAIT_L(0); PG8_MMA(1, 0, At, B0); PG8_BAR; PG8_SCHED;
            PG8_STAGE(PG8_SB(0, 1), b2 + hstep, voffB);
            PG8_WAIT_V(6); PG8_BAR; PG8_MMA(1, 1, At, B1); PG8_BAR;
            PG8_LDB(B0, 1, 0); PG8_SCHED; PG8_LDA(At, 1, 0); PG8_STAGE(PG8_SA(0, 1), a2 + hstep, voffA);
            PG8_WAIT_L(8); PG8_BAR; PG8_WAIT_L(0); PG8_MMA(0, 0, At, B0); PG8_BAR; PG8_SCHED;
            PG8_LDB(B1, 1, 1); PG8_STAGE(PG8_SB(1, 0), b3, voffB);
            PG8_BAR; PG8_WAIT_L(0); PG8_MMA(0, 1, At, B1); PG8_BAR;
            PG8_LDA(At, 1, 1); PG8_STAGE(PG8_SA(1, 0), a3, voffA);
            PG8_BAR; PG8_WAIT_L(0); PG8_MMA(1, 0, At, B0); PG8_BAR; PG8_SCHED;
            PG8_STAGE(PG8_SB(1, 1), b3 + hstep, voffB);
            PG8_WAIT_V(6); PG8_BAR; PG8_MMA(1, 1, At, B1); PG8_BAR;
            }
        }
        if constexpr (ALIGN_EPI) { if (wr == 0) PG8_BAR; }
        if constexpr (!Epi::AFTER_DRAIN) { E(acc, cur, wr, wc, fr, fq, pre); S.done(cur); }
        if (!has_next) break;
#pragma unroll
        for (int a = 0; a < 2; ++a)
#pragma unroll
            for (int b = 0; b < 2; ++b)
#pragma unroll
                for (int m = 0; m < 4; ++m)
#pragma unroll
                    for (int n = 0; n < 2; ++n) acc[a][b][m][n] = (f32x4){0.f, 0.f, 0.f, 0.f};
        cur = nxt; cA = nA; cB = nB; ++ui;
        if constexpr (ALIGN_EPI) { if (wr == 1) PG8_BAR; }
    }
    PG8_WAIT_V(0);
    if constexpr (!ALIGN_EPI) { if (wr == 0) PG8_BAR; }
    PG8_BAR;
    if constexpr (Epi::AFTER_DRAIN) { E.fused(acc, cur, wr, wc, fr, fq, lds, wid, lane); S.done(cur); }
#undef PG8_SA
#undef PG8_SB
#undef PG8_STAGE
#undef PG8_LDA
#undef PG8_LDB
#undef PG8_MMA
#undef PG8_WAIT_V
#undef PG8_WAIT_L
#undef PG8_BAR
#undef PG8_SCHED
}
}

constexpr int D = 4096, NX = 16384, NCX = 256, NT = NX + NCX, NL = 4;
constexpr int NCHK = 130;
constexpr int LDP = 20736;
constexpr int PZ = 0, PXBC = 2048, PU = 5120, PV = 6144, PF = 7168, PG = 8192, PDT = 20480;
constexpr float EPS = 1e-6f;
constexpr int NWAVES = 8, NTHR = 512;
#ifndef KHOOK_ON
#define KHOOK_ON true
#endif

constexpr size_t MiB = 1u << 20;
constexpr size_t WS_CTL = 0;
constexpr size_t WS_MOD = 1 * MiB;
constexpr size_t WS_T1 = 3 * MiB;
constexpr size_t WS_BIN = 4 * MiB;
constexpr size_t WS_TAB = 5 * MiB;
constexpr size_t TAB_CW = 0, TAB_SW = 32768, TAB_SWN = 65536, TAB_TW = 98304, TAB_TWC = 98304 + 131072;
constexpr size_t WS_SGW = 6 * MiB;
constexpr size_t WS_DT = 7 * MiB;
constexpr size_t WS_CS = 12 * MiB;
constexpr size_t WS_EIN = 17 * MiB;
constexpr size_t WS_WEND = 22 * MiB;
constexpr size_t WS_TOT = 27 * MiB;
constexpr size_t WS_RINV = 27 * MiB + 256 * 1024;
constexpr size_t WS_CTXR = 27 * MiB + 512 * 1024;
constexpr size_t WS_SEC = 31 * MiB + 512 * 1024;
constexpr size_t WS_GPC = 33 * MiB + 512 * 1024;
constexpr size_t WS_W = 36 * MiB;
constexpr size_t LW_13A = 0, LW_2A = 64 * MiB, LW_IN = 96 * MiB, LW_BR = 258 * MiB, LW_OUT = 290 * MiB, LW_13B = 322 * MiB, LW_2B = 386 * MiB, LW_SIZE = 418 * MiB;
constexpr size_t WS_H = WS_W + NL * LW_SIZE;
constexpr size_t WS_A = WS_H + 130 * MiB;
constexpr size_t WS_P = WS_A + 130 * MiB;
constexpr size_t WS_XC = WS_P + 659 * MiB;
constexpr size_t WS_XT = WS_XC + 98 * MiB;
constexpr size_t WS_Y = WS_XT + 82 * MiB;
constexpr size_t WS_MG = WS_Y + 130 * MiB;
constexpr size_t WS_LS = WS_MG + 130 * MiB;
constexpr size_t WS_SE = WS_LS + 260 * MiB;
constexpr size_t WS_GPR = WS_SE + 130 * MiB;
constexpr size_t WS_GPI = WS_GPR + 32 * MiB;
constexpr size_t WS_DL = WS_GPI + 32 * MiB;
constexpr size_t WS_DL2 = WS_DL + 130 * MiB;
constexpr size_t WS_END = WS_DL2 + 130 * MiB;
static_assert((size_t)NT * LDP * 2 <= 659 * MiB && (size_t)20736 * 4096 * 2 == 162 * MiB, "map");

constexpr int LDS_BYTES = 155648;
constexpr int LDS_MISC = 151552;

#define LAS __attribute__((address_space(3)))
typedef unsigned short bf16_t;
typedef short v8s __attribute__((ext_vector_type(8)));
typedef short v4s __attribute__((ext_vector_type(4)));
typedef _Float16 v8h __attribute__((ext_vector_type(8)));
typedef _Float16 v2h __attribute__((ext_vector_type(2)));
typedef float f32x4 __attribute__((ext_vector_type(4)));
typedef float f32x2 __attribute__((ext_vector_type(2)));
typedef unsigned u32x4 __attribute__((ext_vector_type(4)));
typedef unsigned u32x2 __attribute__((ext_vector_type(2)));

__device__ __forceinline__ unsigned cvt_pk_bf16(float lo, float hi) { unsigned r; asm volatile("v_cvt_pk_bf16_f32 %0, %1, %2" : "=v"(r) : "v"(lo), "v"(hi)); return r; }
__device__ __forceinline__ float bf_lo(unsigned u) { return __uint_as_float(u << 16); }
__device__ __forceinline__ float bf_hi(unsigned u) { return __uint_as_float(u & 0xffff0000u); }
__device__ __forceinline__ float bf1(bf16_t b) { return __uint_as_float(((unsigned)b) << 16); }
__device__ __forceinline__ bf16_t f2bf(float f) { return (bf16_t)(cvt_pk_bf16(f, 0.f) & 0xffffu); }
__device__ __forceinline__ unsigned pk_f16(float a, float b) { v2h v = {(_Float16)a, (_Float16)b}; return __builtin_bit_cast(unsigned, v); }
__device__ __forceinline__ bf16_t f2h(float a) { _Float16 h = (_Float16)a; return __builtin_bit_cast(unsigned short, h); }
__device__ __forceinline__ f32x4 mma_bf(v8s a, v8s b, f32x4 c) { return __builtin_amdgcn_mfma_f32_16x16x32_bf16(a, b, c, 0, 0, 0); }
__device__ __forceinline__ f32x4 mma_h(v8s a, v8s b, f32x4 c) { return __builtin_amdgcn_mfma_f32_16x16x32_f16(__builtin_bit_cast(v8h, a), __builtin_bit_cast(v8h, b), c, 0, 0, 0); }
__device__ __forceinline__ v8s ld16(const bf16_t* p) { return *(const v8s*)p; }
__device__ __forceinline__ v8s ld8x2(const bf16_t* p0, const bf16_t* p1) { const v4s a = *(const v4s*)p0, b = *(const v4s*)p1; return __builtin_shufflevector(a, b, 0, 1, 2, 3, 4, 5, 6, 7); }
__device__ __forceinline__ v8s pack8_bf(float e0, float e1, float e2, float e3, float e4, float e5, float e6, float e7) {
    u32x4 w; w.x = cvt_pk_bf16(e0, e1); w.y = cvt_pk_bf16(e2, e3); w.z = cvt_pk_bf16(e4, e5); w.w = cvt_pk_bf16(e6, e7); return __builtin_bit_cast(v8s, w); }
__device__ __forceinline__ v8s pack8_h(float e0, float e1, float e2, float e3, float e4, float e5, float e6, float e7) {
    u32x4 w; w.x = pk_f16(e0, e1); w.y = pk_f16(e2, e3); w.z = pk_f16(e4, e5); w.w = pk_f16(e6, e7); return __builtin_bit_cast(v8s, w); }
__device__ __forceinline__ float wave_sum(float v) {
#pragma unroll
    for (int o = 1; o < 64; o <<= 1) v += __shfl_xor(v, o);
    return v;
}
__device__ __forceinline__ float silu_f(float x) { return x * __builtin_amdgcn_rcpf(1.0f + __expf(-x)); }
__device__ __forceinline__ float sigm_f(float x) { return __builtin_amdgcn_rcpf(1.0f + __expf(-x)); }
__device__ __forceinline__ float gelu_f(float x) { const float u = 0.7978845608028654f * (x + 0.044715f * x * x * x); return x * __builtin_amdgcn_rcpf(1.0f + __expf(-2.0f * u)); }
__device__ __forceinline__ float softplus_f(float x) { return fmaxf(x, 0.f) + log1pf(expf(-fabsf(x))); }
__device__ __forceinline__ int chunk_t0(int ci) { return ci < 2 ? NX + 128 * ci : 128 * (ci - 2); }
#define LDS_WAIT() asm volatile("s_waitcnt lgkmcnt(0)" ::: "memory")
#define LDS_BAR() do { asm volatile("s_waitcnt lgkmcnt(0)" ::: "memory"); __builtin_amdgcn_s_barrier(); asm volatile("" ::: "memory"); } while (0)

#define XB_TMO      128
#define XB_XCNT(j)  (256  + 64 * (j))
#define XB_XSUB(j)  (1280 + 64 * (j))
#define XB_XGEN(j)  (2304 + 64 * (j))
#define XB_TOP      3328
#define XB_TOPGEN   3392
#define XCD_BAR_WORDS 3456
#define XB_SPIN_CAP (1u << 18)
__device__ __forceinline__ unsigned xb_ld(unsigned* p)              { return __hip_atomic_load(p, __ATOMIC_RELAXED, __HIP_MEMORY_SCOPE_AGENT); }
__device__ __forceinline__ unsigned xb_add(unsigned* p, unsigned v) { return __hip_atomic_fetch_add(p, v, __ATOMIC_RELAXED, __HIP_MEMORY_SCOPE_AGENT); }
__device__ __forceinline__ unsigned xb_xcc_id() { return (unsigned)__builtin_amdgcn_s_getreg((3 << 11) | 20) & 0xFu; }
#define XB_SPIN(cond, bar) do { unsigned _sp = 0; while (cond) { __builtin_amdgcn_s_sleep(1); \
    if ((++_sp & 255u) == 0u) { if (xb_ld(&(bar)[XB_TMO])) break; if (_sp > XB_SPIN_CAP) { atomicAdd(&(bar)[XB_TMO], 1u); break; } } } } while (0)
struct XcdBarrier { unsigned* bar; unsigned x; volatile LAS unsigned* st; };
__device__ __forceinline__ XcdBarrier xcd_barrier_post(unsigned* bar, volatile LAS unsigned* st) {
    XcdBarrier b; b.bar = bar; b.x = xb_xcc_id(); b.st = st;
    if (threadIdx.x == 0) (void)xb_add(&bar[XB_XCNT(b.x)], 1u);
    return b;
}
__device__ __forceinline__ void xcd_barrier_complete(unsigned* bar, unsigned x, unsigned& nloc, unsigned& nx) {
    const unsigned G = gridDim.x * gridDim.y * gridDim.z;
    unsigned sum, cnt, mine, sp = 0u;
    for (;;) {
        sum = 0u; cnt = 0u; mine = 0u;
#pragma unroll
        for (unsigned j = 0; j < 16; ++j) { const unsigned c = xb_ld(&bar[XB_XCNT(j)]); sum += c; cnt += (c > 0u) ? 1u : 0u; mine = (j == x) ? c : mine; }
        if (sum == G) break;
        __builtin_amdgcn_s_sleep(1);
        if ((++sp & 255u) == 0u) { if (xb_ld(&bar[XB_TMO])) break; if (sp > XB_SPIN_CAP) { atomicAdd(&bar[XB_TMO], 1u); break; } }
    }
    nloc = mine > 0u ? mine : 1u; nx = cnt > 0u ? cnt : 1u;
}
__device__ __forceinline__ void xcd_barrier(const XcdBarrier& b) {
    asm volatile("s_waitcnt vmcnt(0)" ::: "memory");
    __syncthreads();
    if (threadIdx.x == 0) {
        unsigned* bar = b.bar;
        __builtin_amdgcn_s_waitcnt(0);
        unsigned nloc = b.st[0], nx = b.st[1];
        if (nloc == 0u) { xcd_barrier_complete(bar, b.x, nloc, nx); b.st[0] = nloc; b.st[1] = nx; }
        const unsigned old = xb_add(&bar[XB_XSUB(b.x)], 1u);
        const unsigned gen = old / nloc;
        if (old + 1u == (gen + 1u) * nloc) {
            __builtin_amdgcn_fence(__ATOMIC_RELEASE, "agent");
            asm volatile("s_waitcnt vmcnt(0)" ::: "memory");
            const unsigned og = xb_add(&bar[XB_TOP], 1u);
            const unsigned tg = og / nx;
            if (og + 1u == (tg + 1u) * nx) xb_add(&bar[XB_TOPGEN], 1u);
            else XB_SPIN(xb_ld(&bar[XB_TOPGEN]) == tg, bar);
            __builtin_amdgcn_fence(__ATOMIC_ACQUIRE, "agent");
            xb_add(&bar[XB_XGEN(b.x)], 1u);
            asm volatile("s_waitcnt vmcnt(0)" ::: "memory");
        } else {
            XB_SPIN(xb_ld(&bar[XB_XGEN(b.x)]) == gen, bar);
            __builtin_amdgcn_fence(__ATOMIC_ACQUIRE, "agent");
            asm volatile("s_waitcnt vmcnt(0)" ::: "memory");
        }
    }
    __syncthreads();
}

struct Frame {
    LAS unsigned char* lds;
    unsigned char* ws;
    const float* const* in;
    float* out;
    int tid, lane, wave, G, gw, NGW;
};
#define WSP(T, off) ((T*)(F.ws + (off)))

using pg8::Unit;
struct EpiSwiGLU {
    static constexpr bool PERM = true, AFTER_DRAIN = false, KHOOK = false; static constexpr int H1 = -1, H2 = -1;
    bf16_t* O;
    struct Pre {};
    __device__ __forceinline__ void pre_init(Pre&) const {}
    __device__ __forceinline__ void prefetch(Pre&, const Unit&, int, int, int, int) const {}
    __device__ __forceinline__ void khook(f32x4 (&)[2][2][4][2], const Unit&, int, int, int, int, int) const {}
    __device__ __forceinline__ void operator()(const f32x4 (&acc)[2][2][4][2], const Unit& u, int wr, int wc, int fr, int fq, const Pre&) const {
        const int row0 = u.pm * 256 + wr * 64 + fr, col0 = u.pn * 128 + wc * 32 + 8 * fq;
#pragma unroll
        for (int ai = 0; ai < 2; ++ai)
#pragma unroll
            for (int m = 0; m < 4; ++m) {
                const f32x4 a0 = acc[ai][0][m][0], a1 = acc[ai][0][m][1];
                f32x4 t0 = a0 * -1.4426950408889634f, t1 = a1 * -1.4426950408889634f;
#pragma unroll
                for (int j = 0; j < 4; ++j) { t0[j] = __builtin_amdgcn_exp2f(t0[j]); t1[j] = __builtin_amdgcn_exp2f(t1[j]); }
                t0 = t0 + 1.0f; t1 = t1 + 1.0f;
#pragma unroll
                for (int j = 0; j < 4; ++j) { t0[j] = __builtin_amdgcn_rcpf(t0[j]); t1[j] = __builtin_amdgcn_rcpf(t1[j]); }
                const f32x4 o0 = (a0 * acc[ai][1][m][0]) * t0, o1 = (a1 * acc[ai][1][m][1]) * t1;
                u32x4 w; w.x = cvt_pk_bf16(o0[0], o0[1]); w.y = cvt_pk_bf16(o0[2], o0[3]); w.z = cvt_pk_bf16(o1[0], o1[1]); w.w = cvt_pk_bf16(o1[2], o1[3]);
                *(u32x4*)(O + (size_t)(row0 + ai * 128 + m * 16) * D + col0) = w;
            }
    }
};
struct EpiDelta {
    static constexpr bool PERM = true, AFTER_DRAIN = false, KHOOK = false; static constexpr int H1 = -1, H2 = -1;
    bf16_t* O; const float* coefx; const float* coefc; float scale;
    struct Pre { f32x4 cv[2][2]; };
    __device__ __forceinline__ void pre_init(Pre& p) const {
#pragma unroll
        for (int bj = 0; bj < 2; ++bj)
#pragma unroll
            for (int n = 0; n < 2; ++n) p.cv[bj][n] = (f32x4){0.f, 0.f, 0.f, 0.f}; }
    __device__ __forceinline__ void prefetch(Pre& p, const Unit& u, int wr, int wc, int fr, int fq) const {
        const float* coef = (u.pm == 64 ? coefc : coefx) + u.pn * 256 + wc * 32 + 8 * fq;
#pragma unroll
        for (int bj = 0; bj < 2; ++bj)
#pragma unroll
            for (int n = 0; n < 2; ++n) p.cv[bj][n] = *(const f32x4*)(coef + bj * 128 + 4 * n) * scale; }
    __device__ __forceinline__ void khook(f32x4 (&)[2][2][4][2], const Unit&, int, int, int, int, int) const {}
    __device__ __forceinline__ void operator()(const f32x4 (&acc)[2][2][4][2], const Unit& u, int wr, int wc, int fr, int fq, const Pre& p) const {
        const int row0 = u.pm * 256 + wr * 64 + fr, col0 = u.pn * 256 + wc * 32 + 8 * fq;
#pragma unroll
        for (int ai = 0; ai < 2; ++ai)
#pragma unroll
            for (int m = 0; m < 4; ++m) { bf16_t* rowp = O + (size_t)(row0 + ai * 128 + m * 16) * D + col0;
#pragma unroll
                for (int bj = 0; bj < 2; ++bj) { const f32x4 v0 = acc[ai][bj][m][0] * p.cv[bj][0], v1 = acc[ai][bj][m][1] * p.cv[bj][1]; u32x4 w;
                    w.x = cvt_pk_bf16(v0[0], v0[1]); w.y = cvt_pk_bf16(v0[2], v0[3]); w.z = cvt_pk_bf16(v1[0], v1[1]); w.w = cvt_pk_bf16(v1[2], v1[3]);
                    *(u32x4*)(rowp + bj * 128) = w; } }
    }
};
struct EpiProj {
    static constexpr bool PERM = true, AFTER_DRAIN = false, KHOOK = false; static constexpr int H1 = -1, H2 = -1;
    bf16_t* P; float* DT; const float* bias;
    struct Pre { f32x4 bv[2][2]; };
    __device__ __forceinline__ void pre_init(Pre& p) const {
#pragma unroll
        for (int bj = 0; bj < 2; ++bj)
#pragma unroll
            for (int n = 0; n < 2; ++n) p.bv[bj][n] = (f32x4){0.f, 0.f, 0.f, 0.f}; }
    __device__ __forceinline__ void prefetch(Pre& p, const Unit& u, int wr, int wc, int fr, int fq) const {
        const float* b = bias + u.pn * 256 + wc * 32 + 8 * fq;
#pragma unroll
        for (int bj = 0; bj < 2; ++bj)
#pragma unroll
            for (int n = 0; n < 2; ++n) p.bv[bj][n] = *(const f32x4*)(b + bj * 128 + 4 * n); }
    __device__ __forceinline__ void khook(f32x4 (&)[2][2][4][2], const Unit&, int, int, int, int, int) const {}
    __device__ __forceinline__ void operator()(const f32x4 (&acc)[2][2][4][2], const Unit& u, int wr, int wc, int fr, int fq, const Pre& p) const {
        const int row0 = u.pm * 256 + wr * 64 + fr, col0 = u.pn * 256 + wc * 32 + 8 * fq;
        const int pn = u.pn;
        if (pn == 80) {
            if (wc < 2) {
#pragma unroll
                for (int ai = 0; ai < 2; ++ai)
#pragma unroll
                    for (int m = 0; m < 4; ++m) { float* rowp = DT + (size_t)(row0 + ai * 128 + m * 16) * 64 + wc * 32 + 8 * fq;
#pragma unroll
                        for (int n = 0; n < 2; ++n) { const f32x4 v = acc[ai][0][m][n] + p.bv[0][n]; f32x4 o;
#pragma unroll
                            for (int j = 0; j < 4; ++j) o[j] = softplus_f(v[j]);
                            *(f32x4*)(rowp + 4 * n) = o; } }
            }
            return;
        }
        const bool raw = (pn >= 8 && pn < 20) || (pn >= 28 && pn < 32), f16o = (pn >= 28 && pn < 32);
        if (raw) {
#pragma unroll
            for (int ai = 0; ai < 2; ++ai)
#pragma unroll
                for (int m = 0; m < 4; ++m) { bf16_t* rowp = P + (size_t)(row0 + ai * 128 + m * 16) * LDP + col0;
#pragma unroll
                    for (int bj = 0; bj < 2; ++bj) { const f32x4 v0 = acc[ai][bj][m][0] + p.bv[bj][0], v1 = acc[ai][bj][m][1] + p.bv[bj][1]; u32x4 w;
                        if (f16o) { w.x = pk_f16(v0[0], v0[1]); w.y = pk_f16(v0[2], v0[3]); w.z = pk_f16(v1[0], v1[1]); w.w = pk_f16(v1[2], v1[3]); }
                        else { w.x = cvt_pk_bf16(v0[0], v0[1]); w.y = cvt_pk_bf16(v0[2], v0[3]); w.z = cvt_pk_bf16(v1[0], v1[1]); w.w = cvt_pk_bf16(v1[2], v1[3]); }
                        *(u32x4*)(rowp + bj * 128) = w; } }
            return;
        }
        constexpr float NL2E = -1.4426950408889634f;
        if (pn >= 32) {
            f32x4 nb[2][2];
#pragma unroll
            for (int bj = 0; bj < 2; ++bj)
#pragma unroll
                for (int n = 0; n < 2; ++n) nb[bj][n] = p.bv[bj][n] * NL2E;
#pragma unroll
            for (int ai = 0; ai < 2; ++ai)
#pragma unroll
                for (int m = 0; m < 4; ++m) { bf16_t* rowp = P + (size_t)(row0 + ai * 128 + m * 16) * LDP + col0;
#pragma unroll
                    for (int bj = 0; bj < 2; ++bj) { f32x4 v0 = acc[ai][bj][m][0] * NL2E + nb[bj][0], v1 = acc[ai][bj][m][1] * NL2E + nb[bj][1]; u32x4 w;
#pragma unroll
                        for (int j = 0; j < 4; ++j) { v0[j] = __builtin_amdgcn_exp2f(v0[j]); v1[j] = __builtin_amdgcn_exp2f(v1[j]); }
                        v0 = v0 + 1.0f; v1 = v1 + 1.0f;
#pragma unroll
                        for (int j = 0; j < 4; ++j) { v0[j] = __builtin_amdgcn_rcpf(v0[j]); v1[j] = __builtin_amdgcn_rcpf(v1[j]); }
                        w.x = cvt_pk_bf16(v0[0], v0[1]); w.y = cvt_pk_bf16(v0[2], v0[3]); w.z = cvt_pk_bf16(v1[0], v1[1]); w.w = cvt_pk_bf16(v1[2], v1[3]);
                        *(u32x4*)(rowp + bj * 128) = w; } }
            return;
        }
        const bool isg = (pn >= 20 && pn < 28);
        const float c1 = NL2E * (isg ? 1.5957691216057308f : 1.0f), c3 = NL2E * (isg ? 0.07135481627260025f : 0.0f);
#pragma unroll
        for (int ai = 0; ai < 2; ++ai)
#pragma unroll
            for (int m = 0; m < 4; ++m) { bf16_t* rowp = P + (size_t)(row0 + ai * 128 + m * 16) * LDP + col0;
#pragma unroll
                for (int bj = 0; bj < 2; ++bj) { const f32x4 x0 = acc[ai][bj][m][0] + p.bv[bj][0], x1 = acc[ai][bj][m][1] + p.bv[bj][1]; u32x4 w;
                    f32x4 t0 = (x0 * x0 * c3 + c1) * x0, t1 = (x1 * x1 * c3 + c1) * x1;
#pragma unroll
                    for (int j = 0; j < 4; ++j) { t0[j] = __builtin_amdgcn_exp2f(t0[j]); t1[j] = __builtin_amdgcn_exp2f(t1[j]); }
                    t0 = t0 + 1.0f; t1 = t1 + 1.0f;
#pragma unroll
                    for (int j = 0; j < 4; ++j) { t0[j] = __builtin_amdgcn_rcpf(t0[j]); t1[j] = __builtin_amdgcn_rcpf(t1[j]); }
                    t0 = t0 * x0; t1 = t1 * x1;
                    w.x = cvt_pk_bf16(t0[0], t0[1]); w.y = cvt_pk_bf16(t0[2], t0[3]); w.z = cvt_pk_bf16(t1[0], t1[1]); w.w = cvt_pk_bf16(t1[2], t1[3]);
                    *(u32x4*)(rowp + bj * 128) = w; } }
    }
};
struct EpiMerge {
    static constexpr bool PERM = true, AFTER_DRAIN = false, KHOOK = KHOOK_ON; static constexpr int H1 = 32, H2 = 48;
    const bf16_t* P; bf16_t* O;
    struct Pre {};
    __device__ __forceinline__ void pre_init(Pre&) const {}
    __device__ __forceinline__ void prefetch(Pre&, const Unit&, int, int, int, int) const {}
    __device__ __forceinline__ void khook(f32x4 (&acc)[2][2][4][2], const Unit& u, int t, int wr, int wc, int fr, int fq) const {
        const int row0 = u.pm * 256 + wr * 64 + fr, col0 = u.pn * 256 + wc * 32 + 8 * fq;
        const char* nbase = (const char*)(P + PG + (t == 32 ? 0 : D)); const char* dbase = nbase + D * 2;
        unsigned off0 = ((unsigned)row0 * LDP + col0) * 2u; asm volatile("" : "+v"(off0));
#pragma unroll
        for (int ai = 0; ai < 2; ++ai) {
            u32x4 nv[4][2], dv[4][2];
#pragma unroll
            for (int m = 0; m < 4; ++m)
#pragma unroll
                for (int bj = 0; bj < 2; ++bj) { const unsigned off = off0 + (unsigned)((ai * 128 + m * 16) * LDP * 2 + bj * 256); nv[m][bj] = *(const u32x4*)(nbase + off); dv[m][bj] = *(const u32x4*)(dbase + off); }
#pragma unroll
            for (int m = 0; m < 4; ++m)
#pragma unroll
                for (int bj = 0; bj < 2; ++bj) {
                    const u32x4 a = nv[m][bj], b = dv[m][bj];
                    acc[ai][bj][m][0][0] *= bf_lo(a.x) * __builtin_amdgcn_rcpf(bf_lo(b.x)); acc[ai][bj][m][0][1] *= bf_hi(a.x) * __builtin_amdgcn_rcpf(bf_hi(b.x));
                    acc[ai][bj][m][0][2] *= bf_lo(a.y) * __builtin_amdgcn_rcpf(bf_lo(b.y)); acc[ai][bj][m][0][3] *= bf_hi(a.y) * __builtin_amdgcn_rcpf(bf_hi(b.y));
                    acc[ai][bj][m][1][0] *= bf_lo(a.z) * __builtin_amdgcn_rcpf(bf_lo(b.z)); acc[ai][bj][m][1][1] *= bf_hi(a.z) * __builtin_amdgcn_rcpf(bf_hi(b.z));
                    acc[ai][bj][m][1][2] *= bf_lo(a.w) * __builtin_amdgcn_rcpf(bf_lo(b.w)); acc[ai][bj][m][1][3] *= bf_hi(a.w) * __builtin_amdgcn_rcpf(bf_hi(b.w));
                }
            asm volatile("" ::: "memory");
        }
    }
    __device__ __forceinline__ void operator()(const f32x4 (&acc)[2][2][4][2], const Unit& u, int wr, int wc, int fr, int fq, const Pre&) const {
        const int row0 = u.pm * 256 + wr * 64 + fr, col0 = u.pn * 256 + wc * 32 + 8 * fq;
        const bf16_t* g3 = P + PG + 2 * D + col0;
#pragma unroll
        for (int ai = 0; ai < 2; ++ai)
#pragma unroll
            for (int m = 0; m < 4; ++m) { const size_t row = (size_t)(row0 + ai * 128 + m * 16);
#pragma unroll
                for (int bj = 0; bj < 2; ++bj) { const u32x4 g = *(const u32x4*)(g3 + row * LDP + bj * 128); const f32x4 v0 = acc[ai][bj][m][0], v1 = acc[ai][bj][m][1]; u32x4 w;
                    w.x = cvt_pk_bf16(v0[0] * bf_lo(g.x), v0[1] * bf_hi(g.x)); w.y = cvt_pk_bf16(v0[2] * bf_lo(g.y), v0[3] * bf_hi(g.y));
                    w.z = cvt_pk_bf16(v1[0] * bf_lo(g.z), v1[1] * bf_hi(g.z)); w.w = cvt_pk_bf16(v1[2] * bf_lo(g.w), v1[3] * bf_hi(g.w));
                    *(u32x4*)(O + row * D + col0 + bj * 128) = w; } }
    }
};

__device__ __forceinline__ int map_row(int mode, int n) {
    if (mode == 1) return ((n >> 7) << 8) + (n & 127);
    if (mode == 2) return ((n >> 7) << 8) + 128 + (n & 127);
    if (mode == 3) return n < 5120 ? n : (n < 5184 ? PDT + (n - 5120) : n - 64);
    return n;
}
__device__ __forceinline__ void transpose_item(const float* W, int N, bf16_t* WT, int Kdst, int koff, int mode, LAS float* scr, int item, int lane) {
    LAS bf16_t* T = (LAS bf16_t*)scr;
    const int nblk = N / 64, kb = item / nblk, nb_ = item - kb * nblk, k0 = 64 * kb, n0 = 64 * nb_;
    const int lk = lane >> 4, n4 = (lane & 15) * 4;
    f32x4 v[16];
#pragma unroll
    for (int i = 0; i < 16; ++i) v[i] = __builtin_nontemporal_load((const f32x4*)(W + (size_t)(k0 + 4 * i + lk) * N + n0 + n4));
#pragma unroll
    for (int i = 0; i < 16; ++i) { u32x2 w; w.x = cvt_pk_bf16(v[i][0], v[i][1]); w.y = cvt_pk_bf16(v[i][2], v[i][3]); *(LAS u32x2*)(T + (4 * i + lk) * 72 + n4) = w; }
    LDS_WAIT();
    const int r0 = map_row(mode, n0);
    const int g = lane >> 4, i16 = lane & 15, q = i16 >> 2, p = i16 & 3;
#pragma unroll
    for (int nb = 0; nb < 4; ++nb)
#pragma unroll
        for (int kh = 0; kh < 2; ++kh) { const int kc = 4 * kh + g;
            const v4s t0 = __builtin_amdgcn_ds_read_tr16_b64_v4i16((LAS v4s*)(T + (8 * kc + q) * 72 + 16 * nb + 4 * p));
            const v4s t1 = __builtin_amdgcn_ds_read_tr16_b64_v4i16((LAS v4s*)(T + (8 * kc + 4 + q) * 72 + 16 * nb + 4 * p));
            const v8s o = __builtin_shufflevector(t0, t1, 0, 1, 2, 3, 4, 5, 6, 7);
            *(v8s*)(WT + (size_t)(r0 + 16 * nb + i16) * Kdst + koff + k0 + 8 * kc) = o; }
    LDS_WAIT();
}
constexpr int I_SQ = 64 * 64, I_IN = 64 * 321, I_BS = 32 * 64, I_BM = 16 * 64, IL_ITEMS = 7 * I_SQ + I_IN + I_BS + 2 * I_BM;
constexpr int CV_PRO = (int)(0.60 * IL_ITEMS), CV_INP = CV_PRO, CV_MRG = (int)(0.83 * IL_ITEMS);
__device__ __forceinline__ void convert_items(Frame& F, int l, int i0, int i1, int w, int nw) {
    LAS float* scr = (LAS float*)(F.lds + F.wave * 16384);
    bf16_t* wl = WSP(bf16_t, WS_W + (size_t)l * LW_SIZE);
    const size_t sq = (size_t)l * D * D;
    for (int it = i0 + w; it < i1; it += nw) {
        int r = it;
        if (r < I_SQ) { transpose_item(F.in[8] + sq, D, wl + LW_13A / 2, D, 0, 1, scr, r, F.lane); continue; } r -= I_SQ;
        if (r < I_SQ) { transpose_item(F.in[9] + sq, D, wl + LW_13A / 2, D, 0, 2, scr, r, F.lane); continue; } r -= I_SQ;
        if (r < I_SQ) { transpose_item(F.in[10] + sq, D, wl + LW_2A / 2, D, 0, 0, scr, r, F.lane); continue; } r -= I_SQ;
        if (r < I_IN) { transpose_item(F.in[12] + (size_t)l * D * 20544, 20544, wl + LW_IN / 2, D, 0, 3, scr, r, F.lane); continue; } r -= I_IN;
        if (r < I_BS) { transpose_item(F.in[23] + (size_t)l * 2048 * D, D, wl + LW_BR / 2, D, 0, 0, scr, r, F.lane); continue; } r -= I_BS;
        if (r < I_BM) { transpose_item(F.in[24] + (size_t)l * 1024 * D, D, wl + LW_BR / 2, D, 2048, 0, scr, r, F.lane); continue; } r -= I_BM;
        if (r < I_BM) { transpose_item(F.in[25] + (size_t)l * 1024 * D, D, wl + LW_BR / 2, D, 3072, 0, scr, r, F.lane); continue; } r -= I_BM;
        if (r < I_SQ) { transpose_item(F.in[26] + sq, D, wl + LW_OUT / 2, D, 0, 0, scr, r, F.lane); continue; } r -= I_SQ;
        if (r < I_SQ) { transpose_item(F.in[28] + sq, D, wl + LW_13B / 2, D, 0, 1, scr, r, F.lane); continue; } r -= I_SQ;
        if (r < I_SQ) { transpose_item(F.in[29] + sq, D, wl + LW_13B / 2, D, 0, 2, scr, r, F.lane); continue; } r -= I_SQ;
        transpose_item(F.in[30] + sq, D, wl + LW_2B / 2, D, 0, 0, scr, r, F.lane);
    }
}
__device__ __forceinline__ void convert_in_tail(Frame& F, int l, int i0, int i1, int rem) {
    if (l >= NL || (int)blockIdx.x < rem) return;
    convert_items(F, l, i0, i1, ((int)blockIdx.x - rem) * NWAVES + F.wave, (F.G - rem) * NWAVES);
}
__device__ __forceinline__ void prologue_a(Frame& F) {
    for (int it = F.gw; it < IL_ITEMS + (NL - 1) * CV_PRO; it += F.NGW) {
        if (it < IL_ITEMS) convert_items(F, 0, it, it + 1, 0, 1);
        else { const int r = it - IL_ITEMS, l = 1 + r / CV_PRO, i = r % CV_PRO; convert_items(F, l, i, i + 1, 0, 1); }
    }
    const int gt = blockIdx.x * NTHR + F.tid, GT = F.G * NTHR;
    for (int i = gt; i < NL * 192 * (D / 8); i += GT) { const int l = i / (192 * (D / 8)), r = i - l * (192 * (D / 8));
        *(u32x4*)(WSP(bf16_t, WS_W + (size_t)l * LW_SIZE + LW_IN) + (size_t)20544 * D + (size_t)r * 8) = (u32x4){0u, 0u, 0u, 0u}; }
    for (int i = gt; i < NL * LDP; i += GT) { const int l = i / LDP, c = i - l * LDP; float v = 0.f;
        if (c < 5120) v = F.in[13][(size_t)l * 20544 + c];
        else if (c < PDT) v = F.in[13][(size_t)l * 20544 + c + 64];
        else if (c < PDT + 64) v = F.in[13][(size_t)l * 20544 + 5120 + (c - PDT)] + F.in[17][l * 64 + (c - PDT)];
        WSP(float, WS_BIN)[i] = v; }
    for (int i = gt; i < NL * 8 * 128 * 128; i += GT) WSP(bf16_t, WS_SGW)[i] = f2bf(F.in[21][i]);
    for (int i = gt; i < 128 * 128; i += GT) { const int k = i >> 7, n = i & 127; const float a = (float)((k * n) & 127) * (1.0f / 64.0f);
        const float c = cospif(a), s = sinpif(a);
        WSP(bf16_t, WS_TAB + TAB_CW)[i] = f2h(c); WSP(bf16_t, WS_TAB + TAB_SW)[i] = f2h(s); WSP(bf16_t, WS_TAB + TAB_SWN)[i] = f2h(-s);
        const float b = (float)((k * n) & 16383) * (1.0f / 8192.0f);
        WSP(float, WS_TAB + TAB_TW)[2 * i] = cospif(b); WSP(float, WS_TAB + TAB_TW)[2 * i + 1] = sinpif(b); }
    for (int i = gt; i < 128; i += GT) { const float b = (float)i * (1.0f / 128.0f); WSP(float, WS_TAB + TAB_TWC)[2 * i] = cospif(b); WSP(float, WS_TAB + TAB_TWC)[2 * i + 1] = sinpif(b); }
    for (int b = blockIdx.x; b < 2 * NL * 32; b += F.G) {
        const int l = b >> 6, v = (b >> 5) & 1, r = (b & 31) * 8 + F.wave; const float* cv = v ? F.in[3] : F.in[1];
        const float* w1 = F.in[4] + (size_t)l * D * 256 + r; float s_ = 0.f;
#pragma unroll 8
        for (int d = F.lane; d < D; d += 64) s_ += silu_f(cv[d]) * w1[(size_t)d * 256];
        s_ = wave_sum(s_);
        if (F.lane == 0) WSP(float, WS_T1)[(l * 2 + v) * 256 + r] = s_;
    }
}
__device__ __forceinline__ void prologue_b(Frame& F) {
    const int gt = blockIdx.x * NTHR + F.tid, GT = F.G * NTHR;
    for (int i = gt; i < NL * 9 * D; i += GT) { const int l = i / (9 * D), n = i - l * (9 * D);
        const float* w2 = F.in[5] + (size_t)l * 256 * 9 * D + n; const float* t0 = WSP(float, WS_T1) + (l * 2) * 256; const float* t1 = t0 + 256;
        float s0 = 0.f, s1 = 0.f;
#pragma unroll 8
        for (int r = 0; r < 256; ++r) { const float w = w2[(size_t)r * 9 * D]; s0 += t0[r] * w; s1 += t1[r] * w; }
        const float b = F.in[6][(size_t)l * 9 * D + n];
        WSP(float, WS_MOD)[(size_t)(l * 2 + 0) * 9 * D + n] = s0 + b; WSP(float, WS_MOD)[(size_t)(l * 2 + 1) * 9 * D + n] = s1 + b; }
}
__device__ __forceinline__ const float* modv(Frame& F, int l, int v, int j) { return WSP(float, WS_MOD) + ((size_t)(l * 2 + v) * 9 + j) * D; }

struct NormRow { f32x4 x[16]; u32x2 d[16]; };
__device__ __forceinline__ void norm_load(NormRow& R, const float* src, const bf16_t* dl, int lane) {
#pragma unroll
    for (int j = 0; j < 16; ++j) R.x[j] = *(const f32x4*)(src + lane * 4 + 256 * j);
    if (dl) {
#pragma unroll
        for (int j = 0; j < 16; ++j) R.d[j] = *(const u32x2*)(dl + lane * 4 + 256 * j); }
}
__device__ __forceinline__ void norm_rows(Frame& F, const float* xin, const float* cin, float* xout, float* cout, const bf16_t* DL, int row0, int rstride, int rend, const bf16_t* DL2 = nullptr) {
    LAS float* GM = (LAS float*)F.lds; LAS float* SH = GM + 2 * D;
    bf16_t* H = WSP(bf16_t, WS_H);
    NormRow R, Rn;
    int row = row0;
    if (row < rend) { const int v = row >= NX; const size_t ro = v ? (size_t)(row - NX) * D : (size_t)row * D; norm_load(R, (v ? cin : xin) + ro, DL ? DL + (size_t)row * D : DL, F.lane); }
    for (; row < rend; row += rstride) {
        const int rn = row + rstride;
        if (rn < rend) { const int vn = rn >= NX; const size_t rno = vn ? (size_t)(rn - NX) * D : (size_t)rn * D; norm_load(Rn, (vn ? cin : xin) + rno, DL ? DL + (size_t)rn * D : DL, F.lane); }
        const int v = row >= NX; const size_t ro = v ? (size_t)(row - NX) * D : (size_t)row * D;
        float ss = 0.f;
        if (DL) { float* dst = (v ? cout : xout) + ro;
            if (DL2) {
#pragma unroll
                for (int j = 0; j < 16; ++j) { const u32x2 d = *(const u32x2*)(DL2 + (size_t)row * D + F.lane * 4 + 256 * j); R.x[j] = R.x[j] + (f32x4){bf_lo(d.x), bf_hi(d.x), bf_lo(d.y), bf_hi(d.y)}; } }
#pragma unroll
            for (int j = 0; j < 16; ++j) { const u32x2 d = R.d[j];
                R.x[j] = R.x[j] + (f32x4){bf_lo(d.x), bf_hi(d.x), bf_lo(d.y), bf_hi(d.y)}; *(f32x4*)(dst + F.lane * 4 + 256 * j) = R.x[j]; } }
#pragma unroll
        for (int j = 0; j < 16; ++j) ss += (R.x[j][0] * R.x[j][0] + R.x[j][1] * R.x[j][1]) + (R.x[j][2] * R.x[j][2] + R.x[j][3] * R.x[j][3]);
        const float rinv = 1.0f / sqrtf(wave_sum(ss) * (1.0f / D) + EPS);
#pragma unroll
        for (int j = 0; j < 16; ++j) { const int c = F.lane * 4 + 256 * j; const f32x4 gm = *(const LAS f32x4*)(GM + v * D + c), sh = *(const LAS f32x4*)(SH + v * D + c);
            const f32x4 o = R.x[j] * rinv * gm + sh; u32x2 w; w.x = cvt_pk_bf16(o[0], o[1]); w.y = cvt_pk_bf16(o[2], o[3]);
            *(u32x2*)(H + (size_t)row * D + c) = w; }
        if (rn < rend) {
#pragma unroll
            for (int j = 0; j < 16; ++j) { R.x[j] = Rn.x[j]; R.d[j] = Rn.d[j]; } }
    }
}
struct CtxOrder {
    int c;
    __device__ bool next(int i, pg8::Unit& u) const { if (i != 0) return false; u.pm = 64; u.pn = c; return true; }
    __device__ __forceinline__ void a_ready(const pg8::Unit&) const {}
    __device__ __forceinline__ void done(const pg8::Unit&) const {}
};
struct CtxWork { bool on; const bf16_t* A; const bf16_t* Bt; const float* coefc; float scale; unsigned* cnt; };
__device__ __forceinline__ void norm_phase(Frame& F, const float* xin, const float* cin, float* xout, float* cout, const bf16_t* DL, const float* g, int l, int jsh, int nrows, const CtxWork cw) {
    const bool team = cw.on && blockIdx.x < 32;
    if (team) {
        const int kh = (int)blockIdx.x >> 4;
        pg8::Gemm gg{cw.A + kh * 2048, cw.Bt + kh * 2048, NT, D, 2048, D}; CtxOrder S{(int)blockIdx.x & 15}; EpiDelta E{kh ? WSP(bf16_t, WS_DL2) : WSP(bf16_t, WS_DL), cw.coefc, cw.coefc, cw.scale};
        pg8::gemm_phase<EpiDelta, CtxOrder, true, true>(F.lds, gg, S, E);
        __builtin_amdgcn_fence(__ATOMIC_RELEASE, "agent"); asm volatile("s_waitcnt vmcnt(0)" ::: "memory");
        __syncthreads();
        if (F.tid == 0) (void)__hip_atomic_fetch_add(cw.cnt, 1u, __ATOMIC_RELAXED, __HIP_MEMORY_SCOPE_AGENT);
    }
    LAS float* GM = (LAS float*)F.lds;
    LAS float* SH = GM + 2 * D;
    __syncthreads();
    for (int i = F.tid; i < 2 * D; i += NTHR) { const int v = i >> 12, c = i & (D - 1); GM[i] = g[c] * (1.0f + modv(F, l, v, jsh + 1)[c]); SH[i] = modv(F, l, v, jsh)[c]; }
    __syncthreads();
    if (!cw.on) norm_rows(F, xin, cin, xout, cout, DL, F.gw, F.NGW, nrows);
    else if (!team) norm_rows(F, xin, cin, xout, cout, DL, ((int)blockIdx.x - 32) * NWAVES + F.wave, (F.G - 32) * NWAVES, NX);
    else {
        if (F.tid == 0) { unsigned sp = 0; while (__hip_atomic_load(cw.cnt, __ATOMIC_RELAXED, __HIP_MEMORY_SCOPE_AGENT) < 32u) { __builtin_amdgcn_s_sleep(2); if (++sp > (1u << 22)) break; }
            __builtin_amdgcn_fence(__ATOMIC_ACQUIRE, "agent"); asm volatile("s_waitcnt vmcnt(0)" ::: "memory"); }
        __syncthreads();
        norm_rows(F, xin, cin, xout, cout, DL, NX + (int)blockIdx.x * NWAVES + F.wave, 32 * NWAVES, NT, WSP(bf16_t, WS_DL2));
    }
    __syncthreads();
}
__device__ __forceinline__ void final_norm_phase(Frame& F, const bf16_t* DL, const float* g) {
    for (int row = F.gw; row < NX; row += F.NGW) {
        float* src = F.out + (size_t)row * D;
        f32x4 x[16]; float ss = 0.f;
#pragma unroll
        for (int j = 0; j < 16; ++j) { const u32x2 d = *(const u32x2*)(DL + (size_t)row * D + F.lane * 4 + 256 * j);
            x[j] = *(const f32x4*)(src + F.lane * 4 + 256 * j) + (f32x4){bf_lo(d.x), bf_hi(d.x), bf_lo(d.y), bf_hi(d.y)};
            ss += (x[j][0] * x[j][0] + x[j][1] * x[j][1]) + (x[j][2] * x[j][2] + x[j][3] * x[j][3]); }
        const float rinv = 1.0f / sqrtf(wave_sum(ss) * (1.0f / D) + EPS);
#pragma unroll
        for (int j = 0; j < 16; ++j) { const int c = F.lane * 4 + 256 * j; *(f32x4*)(src + c) = x[j] * rinv * *(const f32x4*)(g + c); }
    }
}

struct ConvRegs { u32x4 v[5][2]; };
__device__ __forceinline__ void conv_load(Frame& F, ConvRegs& R, int ci, int cb) {
    const bf16_t* P = WSP(bf16_t, WS_P);
    const int t0 = chunk_t0(ci), q = F.tid >> 2, cq = F.tid & 3, ch0 = cb * 64 + cq * 16, tq = t0 + q;
    const int seg_lo = ci < 2 ? NX : (tq & ~63), seg_hi = ci < 2 ? NT : seg_lo + 64;
#pragma unroll
    for (int k = 0; k < 5; ++k) { const int ts = tq + k - 2; const bool ok = ts >= seg_lo && ts < seg_hi; const int tc = ok ? ts : tq;
        const u32x4 a = *(const u32x4*)(P + (size_t)tc * LDP + PXBC + ch0), b = *(const u32x4*)(P + (size_t)tc * LDP + PXBC + ch0 + 8);
        R.v[k][0] = ok ? a : (u32x4){0u, 0u, 0u, 0u}; R.v[k][1] = ok ? b : (u32x4){0u, 0u, 0u, 0u}; }
}
__device__ __forceinline__ void conv_compute(Frame& F, const ConvRegs& R, int l, int ci, int cb) {
    bf16_t* XC = WSP(bf16_t, WS_XC); bf16_t* XT = WSP(bf16_t, WS_XT);
    LAS bf16_t* T = (LAS bf16_t*)F.lds; constexpr int TS = 136;
    const int t0 = chunk_t0(ci), q = F.tid >> 2, cq = F.tid & 3, ch0 = cb * 64 + cq * 16, tq = t0 + q;
    const LAS float* cw = (const LAS float*)(F.lds + 32768) + ch0; const LAS float* cbv = cw + 5 * 3072;
    float a[16];
#pragma unroll
    for (int j = 0; j < 4; ++j) { const f32x4 b = *(const LAS f32x4*)(cbv + 4 * j); a[4 * j] = b[0]; a[4 * j + 1] = b[1]; a[4 * j + 2] = b[2]; a[4 * j + 3] = b[3]; }
#pragma unroll
    for (int k = 0; k < 5; ++k) { const u32x4 v0 = R.v[k][0], v1 = R.v[k][1];
        const float x[16] = {bf_lo(v0.x), bf_hi(v0.x), bf_lo(v0.y), bf_hi(v0.y), bf_lo(v0.z), bf_hi(v0.z), bf_lo(v0.w), bf_hi(v0.w), bf_lo(v1.x), bf_hi(v1.x), bf_lo(v1.y), bf_hi(v1.y), bf_lo(v1.z), bf_hi(v1.z), bf_lo(v1.w), bf_hi(v1.w)};
#pragma unroll
        for (int j = 0; j < 4; ++j) { const f32x4 w = *(const LAS f32x4*)(cw + k * 3072 + 4 * j); a[4 * j] += w[0] * x[4 * j]; a[4 * j + 1] += w[1] * x[4 * j + 1]; a[4 * j + 2] += w[2] * x[4 * j + 2]; a[4 * j + 3] += w[3] * x[4 * j + 3]; } }
#pragma unroll
    for (int j = 0; j < 16; ++j) a[j] = silu_f(a[j]);
    u32x4 o0, o1; o0.x = cvt_pk_bf16(a[0], a[1]); o0.y = cvt_pk_bf16(a[2], a[3]); o0.z = cvt_pk_bf16(a[4], a[5]); o0.w = cvt_pk_bf16(a[6], a[7]);
    o1.x = cvt_pk_bf16(a[8], a[9]); o1.y = cvt_pk_bf16(a[10], a[11]); o1.z = cvt_pk_bf16(a[12], a[13]); o1.w = cvt_pk_bf16(a[14], a[15]);
    *(u32x4*)(XC + (size_t)tq * 3072 + ch0) = o0; *(u32x4*)(XC + (size_t)tq * 3072 + ch0 + 8) = o1;
    if (cb < 40) {
        const unsigned w[8] = {o0.x, o0.y, o0.z, o0.w, o1.x, o1.y, o1.z, o1.w};
#pragma unroll
        for (int j = 0; j < 8; ++j) { T[(cq * 16 + 2 * j) * TS + q] = (bf16_t)(w[j] & 0xffffu); T[(cq * 16 + 2 * j + 1) * TS + q] = (bf16_t)(w[j] >> 16); }
        LDS_BAR();
        const int r = F.tid >> 3, part = F.tid & 7;
        const u32x4 t0v = *(const LAS u32x4*)(T + r * TS + part * 16), t1v = *(const LAS u32x4*)(T + r * TS + part * 16 + 8);
        bf16_t* dst = XT + (size_t)(cb * 64 + r) * NT + t0 + part * 16;
        *(u32x4*)dst = t0v; *(u32x4*)(dst + 8) = t1v;
        LDS_BAR();
    }
}
__device__ __forceinline__ void conv_all(Frame& F, int l) {
    constexpr int NU = NCHK * 48;
    { LAS float* wl_ = (LAS float*)(F.lds + 32768);
      __syncthreads();
      for (int i = F.tid; i < 5 * 3072 / 4; i += NTHR) *(LAS f32x4*)(wl_ + 4 * i) = *(const f32x4*)(F.in[14] + (size_t)l * 5 * 3072 + 4 * i);
      for (int i = F.tid; i < 3072 / 4; i += NTHR) *(LAS f32x4*)(wl_ + 5 * 3072 + 4 * i) = *(const f32x4*)(F.in[15] + (size_t)l * 3072 + 4 * i);
      __syncthreads(); }
    ConvRegs R0, R1;
    int u = blockIdx.x;
    if (u < NU) conv_load(F, R0, u / 48, u % 48);
    for (; u < NU; u += 2 * F.G) {
        const int u1 = u + F.G, u2 = u + 2 * F.G;
        { const int v1 = u1 < NU ? u1 : u; conv_load(F, R1, v1 / 48, v1 % 48); }
        conv_compute(F, R0, l, u / 48, u % 48);
        { const int v2 = u2 < NU ? u2 : u; conv_load(F, R0, v2 / 48, v2 % 48); }
        if (u1 < NU) conv_compute(F, R1, l, u1 / 48, u1 % 48);
    }
}
__device__ __forceinline__ void cumsum_job(Frame& F, int l, int job) {
    const int ci = job >> 3, d = (job >> 2) & 1, hg = job & 3, t0 = chunk_t0(ci), lane = F.lane, hd = hg * 8 + (lane & 7), sg = lane >> 3;
    const float* DT = WSP(float, WS_DT) + (size_t)(t0 + 16 * sg) * 64 + d * 32 + hd;
    const float Aneg = -expf(F.in[16][l * 64 + d * 32 + hd]);
    float dtv[16]; float part = 0.f;
#pragma unroll
    for (int k = 0; k < 16; ++k) { dtv[k] = DT[(size_t)k * 64]; part += dtv[k] * Aneg; }
    float incl = part;
#pragma unroll
    for (int o = 8; o < 64; o <<= 1) { const float t = __shfl_up(incl, o); if (lane >= o) incl += t; }
    const float total = __shfl(incl, 56 + (lane & 7));
    float run = incl - part;
    const size_t o0 = ((size_t)d * NT + t0 + 16 * sg) * 32 + hd;
    float* CSp = WSP(float, WS_CS) + o0; float* EIp = WSP(float, WS_EIN) + o0; float* WEp = WSP(float, WS_WEND) + o0;
#pragma unroll
    for (int k = 0; k < 16; ++k) { const float dt = dtv[k], a = dt * Aneg;
        const float c = d == 0 ? run + a : total - run;
        run += a;
        CSp[(size_t)k * 32] = c; EIp[(size_t)k * 32] = __expf(c); WEp[(size_t)k * 32] = __expf(total - c) * dt; }
    if (sg == 0) WSP(float, WS_TOT)[(d * NCHK + ci) * 32 + hd] = total;
}
__device__ __forceinline__ void vrms_job4(Frame& F, int tb) {
    u32x4 a[4], b[4]; float ss[4];
#pragma unroll
    for (int r = 0; r < 4; ++r) { const int t = tb + r < NT ? tb + r : NT - 1; const bf16_t* p = WSP(bf16_t, WS_P) + (size_t)t * LDP + PV + F.lane * 16; a[r] = *(const u32x4*)p; b[r] = *(const u32x4*)(p + 8); }
#pragma unroll
    for (int r = 0; r < 4; ++r) { const unsigned w[8] = {a[r].x, a[r].y, a[r].z, a[r].w, b[r].x, b[r].y, b[r].z, b[r].w}; float s_ = 0.f;
#pragma unroll
        for (int j = 0; j < 8; ++j) { const float lo = bf_lo(w[j]), hi = bf_hi(w[j]); s_ += lo * lo + hi * hi; }
        ss[r] = s_; }
#pragma unroll
    for (int o = 1; o < 64; o <<= 1) {
#pragma unroll
        for (int r = 0; r < 4; ++r) ss[r] += __shfl_xor(ss[r], o); }
    if (F.lane < 4 && tb + F.lane < NT) { const float v = F.lane == 0 ? ss[0] : F.lane == 1 ? ss[1] : F.lane == 2 ? ss[2] : ss[3]; WSP(float, WS_RINV)[tb + F.lane] = 1.0f / sqrtf(v * (1.0f / 1024.0f) + EPS); }
}
__device__ __forceinline__ void fft_tables_to_lds(Frame& F, const bf16_t* t0, const bf16_t* t1) {
    LAS bf16_t* L0 = (LAS bf16_t*)(F.lds + 65536); LAS bf16_t* L1 = L0 + 128 * 136;
    __syncthreads();
    for (int i = F.tid; i < 2048; i += NTHR) { const int r = i >> 4, c = (i & 15) * 8; *(LAS u32x4*)(L0 + r * 136 + c) = *(const u32x4*)(t0 + r * 128 + c); *(LAS u32x4*)(L1 + r * 136 + c) = *(const u32x4*)(t1 + r * 128 + c); }
    __syncthreads();
}
__device__ __forceinline__ void fft1_unit(Frame& F, int lb2, int g, int mb) {
    const bf16_t* P = WSP(bf16_t, WS_P);
    bf16_t* GR = WSP(bf16_t, WS_GPR); bf16_t* GI = WSP(bf16_t, WS_GPI);
    LAS bf16_t* LR = (LAS bf16_t*)F.lds;
    LAS bf16_t* LI = LR + 128 * 16 * 8;
    const LAS bf16_t* CWl = (const LAS bf16_t*)(F.lds + 65536); const LAS bf16_t* SWl = CWl + 128 * 136;
    const int w = F.wave, l15 = F.lane & 15, h = F.lane >> 4, l2 = 8 * lb2 + w;
    f32x4 zr[8], zi[8];
    v8s bc[4], bs[4];
    v8s af[8][4];
    const bf16_t* rowb = P + (size_t)(128 * l15 + l2) * LDP + PF + g * 128 + 8 * h;
#pragma unroll
    for (int lb = 0; lb < 4; ++lb)
#pragma unroll
        for (int ks = 0; ks < 4; ++ks) af[lb][ks] = ld16(rowb + (size_t)(2048 * lb) * LDP + 32 * ks);
#pragma unroll
    for (int ks = 0; ks < 4; ++ks) { bc[ks] = *(const LAS v8s*)(CWl + (16 * mb + l15) * 136 + 32 * ks + 8 * h); bs[ks] = *(const LAS v8s*)(SWl + (16 * mb + l15) * 136 + 32 * ks + 8 * h); }
    asm volatile("" ::: "memory");
#pragma unroll
    for (int lb = 4; lb < 8; ++lb)
#pragma unroll
        for (int ks = 0; ks < 4; ++ks) af[lb][ks] = ld16(rowb + (size_t)(2048 * lb) * LDP + 32 * ks);
    asm volatile("" ::: "memory");
#pragma unroll
    for (int lb = 0; lb < 8; ++lb) { zr[lb] = (f32x4){0.f, 0.f, 0.f, 0.f}; zi[lb] = zr[lb];
#pragma unroll
        for (int ks = 0; ks < 4; ++ks) { zr[lb] = mma_h(af[lb][ks], bc[ks], zr[lb]); zi[lb] = mma_h(af[lb][ks], bs[ks], zi[lb]); } }
    v8s br[4], bi[4], bn[4];
#pragma unroll
    for (int ks = 0; ks < 4; ++ks) { const f32x4 a = zr[2 * ks], b = zr[2 * ks + 1], c = zi[2 * ks], d = zi[2 * ks + 1];
        br[ks] = pack8_h(a[0], a[1], a[2], a[3], b[0], b[1], b[2], b[3]); bi[ks] = pack8_h(c[0], c[1], c[2], c[3], d[0], d[1], d[2], d[3]);
        bn[ks] = pack8_h(-c[0], -c[1], -c[2], -c[3], -d[0], -d[1], -d[2], -d[3]); }
    __syncthreads();
#pragma unroll 2
    for (int kb = 0; kb < 8; ++kb) {
        f32x4 gr = {0.f, 0.f, 0.f, 0.f}, gi = gr;
        const LAS bf16_t* cr = CWl + (16 * kb + l15) * 136 + 4 * h; const LAS bf16_t* sr = SWl + (16 * kb + l15) * 136 + 4 * h;
#pragma unroll
        for (int ks = 0; ks < 4; ++ks) {
            const v4s c0 = *(const LAS v4s*)(cr + 32 * ks), c1 = *(const LAS v4s*)(cr + 32 * ks + 16), s0 = *(const LAS v4s*)(sr + 32 * ks), s1 = *(const LAS v4s*)(sr + 32 * ks + 16);
            const v8s ac = __builtin_shufflevector(c0, c1, 0, 1, 2, 3, 4, 5, 6, 7), as = __builtin_shufflevector(s0, s1, 0, 1, 2, 3, 4, 5, 6, 7);
            gr = mma_h(ac, br[ks], gr); gr = mma_h(as, bn[ks], gr); gi = mma_h(ac, bi[ks], gi); gi = mma_h(as, br[ks], gi); }
#pragma unroll
        for (int r = 0; r < 4; ++r) { const int k1 = 16 * kb + 4 * h + r; const float ang = (float)((k1 * l2) & 16383) * (1.0f / 16384.0f);
            const float ct = __builtin_amdgcn_cosf(ang), st = __builtin_amdgcn_sinf(ang);
            const float pr = gr[r] * ct - gi[r] * st, pi = gr[r] * st + gi[r] * ct;
            LR[(k1 * 16 + l15) * 8 + w] = f2h(pr); LI[(k1 * 16 + l15) * 8 + w] = f2h(pi); }
    }
    __syncthreads();
#pragma unroll
    for (int j = 0; j < 4; ++j) { const int p = F.tid + NTHR * j, k1 = p >> 4, c = p & 15;
        const size_t o = ((size_t)k1 * 1024 + g * 128 + 16 * mb + c) * 128 + 8 * lb2;
        *(u32x4*)(GR + o) = *(const LAS u32x4*)(LR + p * 8); *(u32x4*)(GI + o) = *(const LAS u32x4*)(LI + p * 8); }
}
__device__ __forceinline__ void fft1c_unit(Frame& F, int g) {
    const bf16_t* P = WSP(bf16_t, WS_P); const bf16_t* CW = WSP(bf16_t, WS_TAB + TAB_CW); const bf16_t* SW = WSP(bf16_t, WS_TAB + TAB_SW);
    const float* TWC = WSP(float, WS_TAB + TAB_TWC);
    bf16_t* GR = WSP(bf16_t, WS_GPC); bf16_t* GI = WSP(bf16_t, WS_GPC + MiB);
    const int w = F.wave, l15 = F.lane & 15, h = F.lane >> 4;
    v8s bc[4], bs[4];
#pragma unroll
    for (int ks = 0; ks < 4; ++ks) { bc[ks] = ld16(CW + (16 * w + l15) * 128 + 32 * ks + 8 * h); bs[ks] = ld16(SW + (16 * w + l15) * 128 + 32 * ks + 8 * h); }
    const int ch = g * 128 + 16 * w + l15;
#pragma unroll 1
    for (int lb = 0; lb < 8; ++lb) {
        f32x4 ar = {0.f, 0.f, 0.f, 0.f}, ai = ar, br = ar, bi = ar;
        const bf16_t* ra = P + (size_t)(NX + 16 * lb + l15) * LDP + PF + g * 128 + 8 * h; const bf16_t* rb = ra + (size_t)128 * LDP;
#pragma unroll
        for (int ks = 0; ks < 4; ++ks) { const v8s a = ld16(ra + 32 * ks), b = ld16(rb + 32 * ks);
            ar = mma_h(a, bc[ks], ar); ai = mma_h(a, bs[ks], ai); br = mma_h(b, bc[ks], br); bi = mma_h(b, bs[ks], bi); }
        unsigned short o0r[4], o0i[4], o1r[4], o1i[4];
#pragma unroll
        for (int r = 0; r < 4; ++r) { const int l2 = 16 * lb + 4 * h + r; const f32x2 tw = *(const f32x2*)(TWC + 2 * l2);
            const float sr = ar[r] + br[r], si = ai[r] + bi[r], dr = ar[r] - br[r], di = ai[r] - bi[r];
            o0r[r] = f2h(sr); o0i[r] = f2h(si); o1r[r] = f2h(dr * tw.x - di * tw.y); o1i[r] = f2h(dr * tw.y + di * tw.x); }
        const size_t o0 = ((size_t)0 * 1024 + ch) * 128 + 16 * lb + 4 * h, o1 = ((size_t)1 * 1024 + ch) * 128 + 16 * lb + 4 * h;
        *(u32x2*)(GR + o0) = (u32x2){(unsigned)o0r[0] | ((unsigned)o0r[1] << 16), (unsigned)o0r[2] | ((unsigned)o0r[3] << 16)};
        *(u32x2*)(GI + o0) = (u32x2){(unsigned)o0i[0] | ((unsigned)o0i[1] << 16), (unsigned)o0i[2] | ((unsigned)o0i[3] << 16)};
        *(u32x2*)(GR + o1) = (u32x2){(unsigned)o1r[0] | ((unsigned)o1r[1] << 16), (unsigned)o1r[2] | ((unsigned)o1r[3] << 16)};
        *(u32x2*)(GI + o1) = (u32x2){(unsigned)o1i[0] | ((unsigned)o1i[1] << 16), (unsigned)o1i[2] | ((unsigned)o1i[3] << 16)};
    }
}
__device__ __forceinline__ void fft2_unit(Frame& F, const bf16_t* GR, const bf16_t* GI, int k1, int g, int rowbase, int KS, float scale) {
    const LAS bf16_t* CWl = (const LAS bf16_t*)(F.lds + 65536); const LAS bf16_t* SNl = CWl + 128 * 136;
    bf16_t* Y = WSP(bf16_t, WS_Y);
    const int w = F.wave, l15 = F.lane & 15, h = F.lane >> 4;
    v8s ar[4], ai[4];
    const size_t ab = ((size_t)k1 * 1024 + g * 128 + 16 * w + l15) * 128 + 8 * h;
#pragma unroll
    for (int ks = 0; ks < 4; ++ks) { ar[ks] = ld16(GR + ab + 32 * ks); ai[ks] = ld16(GI + ab + 32 * ks); }
#pragma unroll 2
    for (int kb = 0; kb < 8; ++kb) {
        f32x4 acc = {0.f, 0.f, 0.f, 0.f};
        const LAS bf16_t* cr = CWl + (16 * kb + l15) * 136 + 8 * h; const LAS bf16_t* sr = SNl + (16 * kb + l15) * 136 + 8 * h;
#pragma unroll
        for (int ks = 0; ks < 4; ++ks) { acc = mma_h(ar[ks], *(const LAS v8s*)(cr + 32 * ks), acc); acc = mma_h(ai[ks], *(const LAS v8s*)(sr + 32 * ks), acc); }
        const int row = rowbase + k1 + KS * (16 * kb + l15);
        u32x2 o; o.x = cvt_pk_bf16(acc[0] * scale, acc[1] * scale); o.y = cvt_pk_bf16(acc[2] * scale, acc[3] * scale);
        *(u32x2*)(Y + (size_t)row * D + 3072 + g * 128 + 16 * w + 4 * h) = o;
    }
}

struct LocPF { u32x4 x[2]; float w; };
__device__ __forceinline__ void loc_pf_x(Frame& F, LocPF& P, int t0, int hd) {
    const bf16_t* XT = WSP(bf16_t, WS_XT);
#pragma unroll
    for (int j = 0; j < 2; ++j) { const int id = F.tid + NTHR * j, row = id >> 4, c = (id & 15) * 8; P.x[j] = *(const u32x4*)(XT + (size_t)(hd * 64 + row) * NT + t0 + c); }
    { const int t = F.tid & 255, dd = t >> 7, s_ = t & 127; P.w = WSP(float, WS_WEND)[((size_t)dd * NT + t0 + s_) * 32 + hd]; }
}
__device__ __forceinline__ void loc_commit_x(Frame& F, const LocPF& P, LAS bf16_t* XAl, LAS float* wl) {
#pragma unroll
    for (int j = 0; j < 2; ++j) { const int id = F.tid + NTHR * j, row = id >> 4, c = (id & 15) * 8; *(LAS u32x4*)(XAl + row * 136 + c) = P.x[j]; }
    if (F.tid < 256) wl[F.tid] = P.w;
}
__device__ __forceinline__ void ssd_local_unit4(Frame& F, int ci, int hd0) {
    const bf16_t* XT = WSP(bf16_t, WS_XT); bf16_t* LS = WSP(bf16_t, WS_LS);
    LAS bf16_t* BTl = (LAS bf16_t*)F.lds;
    LAS bf16_t* XAl = BTl + 128 * 136;
    LAS float* wl = (LAS float*)(XAl + 64 * 136);
    const int t0 = chunk_t0(ci), g = hd0 >> 3, w = F.wave, l15 = F.lane & 15, h = F.lane >> 4, d = w >> 2, nq = w & 3;
    u32x4 pb_[4]; LocPF P;
#pragma unroll
    for (int j = 0; j < 4; ++j) { const int id = F.tid + NTHR * j, row = id >> 4, c = (id & 15) * 8; pb_[j] = *(const u32x4*)(XT + (size_t)(2048 + g * 128 + row) * NT + t0 + c); }
    loc_pf_x(F, P, t0, hd0);
    LDS_BAR();
#pragma unroll
    for (int j = 0; j < 4; ++j) { const int id = F.tid + NTHR * j, row = id >> 4, c = (id & 15) * 8; *(LAS u32x4*)(BTl + row * 136 + c) = pb_[j]; }
    loc_commit_x(F, P, XAl, wl);
    loc_pf_x(F, P, t0, hd0 + 1);
    LDS_BAR();
    v8s bfr[4][2];
#pragma unroll
    for (int ks = 0; ks < 4; ++ks)
#pragma unroll
        for (int nb = 0; nb < 2; ++nb) bfr[ks][nb] = *(const LAS v8s*)(BTl + (nq * 32 + 16 * nb + l15) * 136 + 32 * ks + 8 * h);
#pragma unroll
    for (int j = 0; j < 4; ++j) {
        const int hd = hd0 + j;
        if (j > 0) LDS_BAR();
        f32x4 acc[4][2];
#pragma unroll
        for (int pb = 0; pb < 4; ++pb) { acc[pb][0] = (f32x4){0.f, 0.f, 0.f, 0.f}; acc[pb][1] = acc[pb][0]; }
#pragma unroll
        for (int ks = 0; ks < 4; ++ks) {
            const f32x4 w0 = *(const LAS f32x4*)(wl + d * 128 + 32 * ks + 8 * h), w1 = *(const LAS f32x4*)(wl + d * 128 + 32 * ks + 8 * h + 4);
#pragma unroll
            for (int pb = 0; pb < 4; ++pb) {
                const u32x4 raw = *(const LAS u32x4*)(XAl + (16 * pb + l15) * 136 + 32 * ks + 8 * h);
                const v8s a = pack8_bf(bf_lo(raw.x) * w0[0], bf_hi(raw.x) * w0[1], bf_lo(raw.y) * w0[2], bf_hi(raw.y) * w0[3], bf_lo(raw.z) * w1[0], bf_hi(raw.z) * w1[1], bf_lo(raw.w) * w1[2], bf_hi(raw.w) * w1[3]);
                acc[pb][0] = mma_bf(bfr[ks][0], a, acc[pb][0]); acc[pb][1] = mma_bf(bfr[ks][1], a, acc[pb][1]);
            }
        }
        if (j < 3) { LDS_BAR(); loc_commit_x(F, P, XAl, wl); if (j < 2) loc_pf_x(F, P, t0, hd + 2); }
        bf16_t* dst = LS + ((size_t)(d * NCHK + ci) * 32 + hd) * 8192;
#pragma unroll
        for (int pb = 0; pb < 4; ++pb)
#pragma unroll
            for (int nb = 0; nb < 2; ++nb) { u32x2 o; o.x = cvt_pk_bf16(acc[pb][nb][0], acc[pb][nb][1]); o.y = cvt_pk_bf16(acc[pb][nb][2], acc[pb][nb][3]);
                *(u32x2*)(dst + (16 * pb + l15) * 128 + nq * 32 + 16 * nb + 4 * h) = o; }
        if (ci < 2) {
            bf16_t* sec = WSP(bf16_t, WS_SEC) + ((size_t)(d * 2 + (1 - ci)) * 32 + hd) * 8192; const bool keep = (d == ci);
#pragma unroll
            for (int pb = 0; pb < 4; ++pb)
#pragma unroll
                for (int nb = 0; nb < 2; ++nb)
                    { u32x2 o; o.x = keep ? cvt_pk_bf16(acc[pb][nb][0], acc[pb][nb][1]) : 0u; o.y = keep ? cvt_pk_bf16(acc[pb][nb][2], acc[pb][nb][3]) : 0u; *(u32x2*)(sec + (16 * pb + l15) * 128 + nq * 32 + 16 * nb + 4 * h) = o; }
        }
    }
}
__device__ __forceinline__ void sgu_unit(Frame& F, int l, int ci, int g) {
    const bf16_t* P = WSP(bf16_t, WS_P); bf16_t* Y = WSP(bf16_t, WS_Y);
    LAS bf16_t* VT = (LAS bf16_t*)F.lds; constexpr int VS = 136;
    const int t0 = chunk_t0(ci), w = F.wave, lane = F.lane, l15 = lane & 15, h = lane >> 4;
    __syncthreads();
    { const int row = F.tid >> 2, c0 = (F.tid & 3) * 32; const float ri = WSP(float, WS_RINV)[t0 + row];
      const float* gn = F.in[20] + (size_t)l * 1024 + g * 128 + c0;
#pragma unroll
      for (int j = 0; j < 4; ++j) { const u32x4 v = *(const u32x4*)(P + (size_t)(t0 + row) * LDP + PV + g * 128 + c0 + 8 * j);
          const f32x4 g0 = *(const f32x4*)(gn + 8 * j), g1 = *(const f32x4*)(gn + 8 * j + 4); u32x4 o;
          o.x = cvt_pk_bf16(bf_lo(v.x) * ri * g0[0], bf_hi(v.x) * ri * g0[1]); o.y = cvt_pk_bf16(bf_lo(v.y) * ri * g0[2], bf_hi(v.y) * ri * g0[3]);
          o.z = cvt_pk_bf16(bf_lo(v.z) * ri * g1[0], bf_hi(v.z) * ri * g1[1]); o.w = cvt_pk_bf16(bf_lo(v.w) * ri * g1[2], bf_hi(v.w) * ri * g1[3]);
          *(LAS u32x4*)(VT + row * VS + c0 + 8 * j) = o; } }
    __syncthreads();
    const bf16_t* Ws = WSP(bf16_t, WS_SGW) + ((size_t)(l * 8 + g) * 128 + 16 * w + l15) * 128 + 8 * h;
    v8s bw[4];
#pragma unroll
    for (int ks = 0; ks < 4; ++ks) bw[ks] = ld16(Ws + 32 * ks);
    const int q = 16 * w + l15; const float bq = F.in[22][(size_t)l * 1024 + g * 128 + q];
#pragma unroll 2
    for (int cb = 0; cb < 8; ++cb) {
        f32x4 acc = {0.f, 0.f, 0.f, 0.f};
#pragma unroll
        for (int ks = 0; ks < 4; ++ks) {
            const int rb = 32 * ks + 8 * h + (l15 >> 2), cc = 16 * cb + 4 * (lane & 3);
            const v4s t0v = __builtin_amdgcn_ds_read_tr16_b64_v4i16((LAS v4s*)(VT + rb * VS + cc));
            const v4s t1v = __builtin_amdgcn_ds_read_tr16_b64_v4i16((LAS v4s*)(VT + (rb + 4) * VS + cc));
            const v8s a = __builtin_shufflevector(t0v, t1v, 0, 1, 2, 3, 4, 5, 6, 7);
            acc = mma_bf(a, bw[ks], acc);
        }
        const size_t rowo = (size_t)(t0 + q);
        const u32x2 uu = *(const u32x2*)(P + rowo * LDP + PU + g * 128 + 16 * cb + 4 * h);
        u32x2 o; o.x = cvt_pk_bf16(bf_lo(uu.x) * (acc[0] + bq), bf_hi(uu.x) * (acc[1] + bq)); o.y = cvt_pk_bf16(bf_lo(uu.y) * (acc[2] + bq), bf_hi(uu.y) * (acc[3] + bq));
        *(u32x2*)(Y + rowo * D + 2048 + g * 128 + 16 * cb + 4 * h) = o;
    }
}

template <int NE>
__device__ __forceinline__ void scan_elems(Frame& F, const int (&e)[NE]) {
    const bf16_t* LS = WSP(bf16_t, WS_LS); const float* TOT = WSP(float, WS_TOT); bf16_t* SE = WSP(bf16_t, WS_SE);
    int d[NE], hd[NE], pn4[NE]; f32x4 S[NE];
#pragma unroll
    for (int j = 0; j < NE; ++j) { d[j] = e[j] >> 16; hd[j] = (e[j] >> 11) & 31; pn4[j] = e[j] & 2047; S[j] = (f32x4){0.f, 0.f, 0.f, 0.f}; }
#pragma unroll 1
    for (int s0 = 0; s0 < NCHK; s0 += 5) {
        f32x4 ls[NE][5]; float dc[NE][5]; size_t off[NE][5];
#pragma unroll
        for (int j = 0; j < NE; ++j)
#pragma unroll
            for (int k = 0; k < 5; ++k) { const int step = s0 + k; const int ci = d[j] == 0 ? step : (step < 2 ? 1 - step : 131 - step);
                off[j][k] = ((size_t)(d[j] * NCHK + ci) * 32 + hd[j]) * 8192 + (size_t)pn4[j] * 4; const u32x2 lv = *(const u32x2*)(LS + off[j][k]);
                ls[j][k] = (f32x4){bf_lo(lv.x), bf_hi(lv.x), bf_lo(lv.y), bf_hi(lv.y)}; dc[j][k] = TOT[(d[j] * NCHK + ci) * 32 + hd[j]]; }
#pragma unroll
        for (int j = 0; j < NE; ++j)
#pragma unroll
            for (int k = 0; k < 5; ++k) { u32x2 o; o.x = cvt_pk_bf16(S[j][0], S[j][1]); o.y = cvt_pk_bf16(S[j][2], S[j][3]); *(u32x2*)(SE + off[j][k]) = o; S[j] = S[j] * expf(dc[j][k]) + ls[j][k]; }
    }
}
__device__ __forceinline__ void scan_phase(Frame& F, int nskip) {
    const int b = (int)blockIdx.x;
    if (F.G != 256 || nskip == 0) { for (int e = b * NTHR + F.tid; e < 131072; e += F.G * NTHR) { const int ee[1] = {e}; scan_elems<1>(F, ee); } return; }
    if (b < nskip) return;
    const int e1 = (b - nskip) * NTHR + F.tid;
    if (b < 2 * nskip) { const int ee[2] = {e1, (256 - nskip) * NTHR + (b - nskip) * NTHR + F.tid}; scan_elems<2>(F, ee); }
    else { const int ee[1] = {e1}; scan_elems<1>(F, ee); }
}

struct PF8 { u32x4 x[2], s0[2], s1[2], z[2]; };
__device__ __forceinline__ void ssd_prefetch(PF8& pf, const bf16_t* XTc, const bf16_t* SE0, const bf16_t* SE1, const bf16_t* Pz, int hd, int tid, int lane) {
#pragma unroll
    for (int j = 0; j < 2; ++j) { const int id = tid + NTHR * j, row = id >> 4, c = (id & 15) * 8;
        pf.x[j] = *(const u32x4*)(XTc + (size_t)(hd * 64 + row) * NT + c);
        pf.s0[j] = *(const u32x4*)(SE0 + ((size_t)hd * 64 + row) * 128 + c); pf.s1[j] = *(const u32x4*)(SE1 + ((size_t)hd * 64 + row) * 128 + c); }
#pragma unroll
    for (int j = 0; j < 2; ++j) { const int id = lane + 64 * j, row = id >> 3, c = (id & 7) * 8; pf.z[j] = *(const u32x4*)(Pz + (size_t)row * LDP + hd * 64 + c); }
}
__device__ __forceinline__ void ssd_commit(const PF8& pf, LAS bf16_t* XTt, LAS bf16_t* SEt, LAS bf16_t* Zw, int tid, int lane) {
#pragma unroll
    for (int j = 0; j < 2; ++j) { const int id = tid + NTHR * j, row = id >> 4, c = (id & 15) * 8;
        *(LAS u32x4*)(XTt + row * 136 + c) = pf.x[j]; *(LAS u32x4*)(SEt + row * 136 + c) = pf.s0[j]; *(LAS u32x4*)(SEt + 64 * 136 + row * 136 + c) = pf.s1[j]; }
#pragma unroll
    for (int j = 0; j < 2; ++j) { const int id = lane + 64 * j, row = id >> 3, c = (id & 7) * 8; *(LAS u32x4*)(Zw + row * 72 + c) = pf.z[j]; }
}
__device__ __forceinline__ void ssd_out_unit(Frame& F, int l, int ci, int g, const bf16_t* SE0, const bf16_t* SE1) {
    const bf16_t* XC = WSP(bf16_t, WS_XC); const bf16_t* P = WSP(bf16_t, WS_P);
    const float* CS = WSP(float, WS_CS); const float* EIN = WSP(float, WS_EIN); const float* DT = WSP(float, WS_DT); bf16_t* Y = WSP(bf16_t, WS_Y);
    LAS float* csT = (LAS float*)F.lds;
    LAS float* dtT = csT + 2048;
    LAS float* eiT = csT + 4096;
    LAS bf16_t* XTt = (LAS bf16_t*)(F.lds + 24576);
    LAS bf16_t* SEt = XTt + 64 * 136;
    LAS bf16_t* Zw = (LAS bf16_t*)(F.lds + 24576 + 3 * 17408) + F.wave * (16 * 72);
    LAS float* RS = (LAS float*)(F.lds + 24576 + 3 * 17408 + 8 * 2304) + F.wave * 16;
    const int t0 = chunk_t0(ci), w = F.wave, lane = F.lane, l15 = lane & 15, h = lane >> 4;
    const bf16_t* XTc = WSP(bf16_t, WS_XT) + t0; const bf16_t* Pz = P + (size_t)(t0 + 16 * w) * LDP + PZ;
    PF8 pf;
    ssd_prefetch(pf, XTc, SE0, SE1, Pz, g * 8, F.tid, lane);
    LDS_BAR();
    for (int i = F.tid; i < 2048; i += NTHR) { const int d = i >> 10, r = (i >> 7) & 7, s = i & 127, hd = g * 8 + r; const size_t ix = ((size_t)d * NT + t0 + s) * 32 + hd;
        csT[i] = CS[ix]; eiT[i] = EIN[ix]; dtT[i] = DT[(size_t)(t0 + s) * 64 + d * 32 + hd]; }
    ssd_commit(pf, XTt, SEt, Zw, F.tid, lane);
    ssd_prefetch(pf, XTc, SE0, SE1, Pz, g * 8 + 1, F.tid, lane);
    v8s cf[4];
#pragma unroll
    for (int ks = 0; ks < 4; ++ks) cf[ks] = ld16(XC + (size_t)(t0 + 16 * w + l15) * 3072 + 2560 + g * 128 + 32 * ks + 8 * h);
    f32x4 cbt[8];
#pragma unroll
    for (int sb = 0; sb < 8; ++sb) { cbt[sb] = (f32x4){0.f, 0.f, 0.f, 0.f};
#pragma unroll
        for (int ks = 0; ks < 4; ++ks) cbt[sb] = mma_bf(ld16(XC + (size_t)(t0 + 16 * sb + l15) * 3072 + 2048 + g * 128 + 32 * ks + 8 * h), cf[ks], cbt[sb]); }
    float ss[4] = {0.f, 0.f, 0.f, 0.f};
    const int qa = 16 * w + l15;
    const int wh = w >> 1;
#pragma unroll 1
    for (int r = 0; r < 8; ++r) {
        LDS_BAR();
        const int hd = g * 8 + r;
        const float csq0 = csT[r * 128 + qa], csq1 = csT[(8 + r) * 128 + qa];
        f32x4 acc[4];
#pragma unroll
        for (int pb = 0; pb < 4; ++pb) acc[pb] = (f32x4){0.f, 0.f, 0.f, 0.f};
#pragma unroll
        for (int ks = 0; ks < 4; ++ks) {
            v8s bx[4];
#pragma unroll
            for (int pb = 0; pb < 4; ++pb) { const LAS bf16_t* xp = XTt + (16 * pb + l15) * 136 + 32 * ks + 4 * h; const v4s lo = *(const LAS v4s*)xp, hi = *(const LAS v4s*)(xp + 16); bx[pb] = __builtin_shufflevector(lo, hi, 0, 1, 2, 3, 4, 5, 6, 7); }
#pragma unroll
            for (int d = 0; d < 2; ++d) {
                const bool active = d == 0 ? (ks <= wh) : (ks >= wh);
                if (active) {
                    float e[8];
#pragma unroll
                    for (int hf = 0; hf < 2; ++hf) { const int sb = 2 * ks + hf, sbase = 16 * sb + 4 * h;
                        const f32x4 c4 = *(const LAS f32x4*)(csT + (d * 8 + r) * 128 + sbase), d4 = *(const LAS f32x4*)(dtT + (d * 8 + r) * 128 + sbase);
#pragma unroll
                        for (int i = 0; i < 4; ++i) { const int s = sbase + i; const bool ok = d == 0 ? (qa >= s) : (qa <= s);
                            const float arg = fminf((d == 0 ? csq0 : csq1) - c4[i], 0.f);
                            e[4 * hf + i] = ok ? cbt[sb][i] * __expf(arg) * d4[i] : 0.f; } }
                    const v8s af = pack8_bf(e[0], e[1], e[2], e[3], e[4], e[5], e[6], e[7]);
#pragma unroll
                    for (int pb = 0; pb < 4; ++pb) acc[pb] = mma_bf(af, bx[pb], acc[pb]);
                }
            }
        }
#pragma unroll
        for (int d = 0; d < 2; ++d) {
            const float eq = eiT[(d * 8 + r) * 128 + qa];
#pragma unroll
            for (int ks = 0; ks < 4; ++ks) { const u32x4 raw = __builtin_bit_cast(u32x4, cf[ks]);
                const v8s a = pack8_bf(bf_lo(raw.x) * eq, bf_hi(raw.x) * eq, bf_lo(raw.y) * eq, bf_hi(raw.y) * eq, bf_lo(raw.z) * eq, bf_hi(raw.z) * eq, bf_lo(raw.w) * eq, bf_hi(raw.w) * eq);
#pragma unroll
                for (int pb = 0; pb < 4; ++pb) acc[pb] = mma_bf(a, *(const LAS v8s*)(SEt + d * (64 * 136) + (16 * pb + l15) * 136 + 32 * ks + 8 * h), acc[pb]); }
        }
        const float dsk = F.in[18][l * 32 + hd];
#pragma unroll
        for (int pb = 0; pb < 4; ++pb) {
            const u32x2 x4 = *(const LAS u32x2*)(XTt + (16 * pb + l15) * 136 + 16 * w + 4 * h);
            const float xs[4] = {bf_lo(x4.x), bf_hi(x4.x), bf_lo(x4.y), bf_hi(x4.y)};
#pragma unroll
            for (int i = 0; i < 4; ++i) { const int ql = 4 * h + i; const float z = bf1(Zw[ql * 72 + 16 * pb + l15]);
                const float y = (acc[pb][i] + dsk * xs[i]) * z; ss[i] += y * y;
                Y[(size_t)(t0 + 16 * w + ql) * D + hd * 64 + 16 * pb + l15] = f2bf(y); }
        }
        LDS_BAR();
        if (r < 7) { ssd_commit(pf, XTt, SEt, Zw, F.tid, lane); if (r < 6) ssd_prefetch(pf, XTc, SE0, SE1, Pz, g * 8 + r + 2, F.tid, lane); }
    }
#pragma unroll
    for (int i = 0; i < 4; ++i) { float v = ss[i]; v += __shfl_xor(v, 1); v += __shfl_xor(v, 2); v += __shfl_xor(v, 4); v += __shfl_xor(v, 8);
        if (l15 == 0) RS[4 * h + i] = 1.0f / sqrtf(v * (1.0f / 512.0f) + EPS); }
    asm volatile("s_waitcnt vmcnt(0) lgkmcnt(0)" ::: "memory");
    { const float* gn = F.in[19] + (size_t)l * 2048 + g * 512 + lane * 8; const f32x4 g0 = *(const f32x4*)gn, g1 = *(const f32x4*)(gn + 4);
#pragma unroll 4
      for (int k = 0; k < 16; ++k) { bf16_t* yp = Y + (size_t)(t0 + 16 * w + k) * D + g * 512 + lane * 8; const u32x4 v = *(const u32x4*)yp; const float rk = RS[k]; u32x4 o;
          o.x = cvt_pk_bf16(bf_lo(v.x) * rk * g0[0], bf_hi(v.x) * rk * g0[1]); o.y = cvt_pk_bf16(bf_lo(v.y) * rk * g0[2], bf_hi(v.y) * rk * g0[3]);
          o.z = cvt_pk_bf16(bf_lo(v.z) * rk * g1[0], bf_hi(v.z) * rk * g1[1]); o.w = cvt_pk_bf16(bf_lo(v.w) * rk * g1[2], bf_hi(v.w) * rk * g1[3]);
          *(u32x4*)yp = o; } }
}

#ifndef SKIPM
#define SKIPM 0
#endif
#ifndef REPM
#define REPM 0
#endif
#ifndef REPA
#define REPA 0
#endif
#ifndef REPB
#define REPB 0
#endif
struct Args { const float* in[32]; float* out; unsigned char* ws; int ph_lo, ph_hi; };
constexpr int N_PHASES = 2 + 14 * NL + 1;

__global__ void __launch_bounds__(NTHR, 2) trunk_fwd(Args args) {
    extern __shared__ __attribute__((aligned(16))) unsigned char lds_raw[];
    Frame F;
    F.lds = (LAS unsigned char*)lds_raw; F.ws = args.ws; F.in = args.in; F.out = args.out;
    F.tid = threadIdx.x; F.lane = F.tid & 63; F.wave = __builtin_amdgcn_readfirstlane(F.tid >> 6);
    F.G = gridDim.x; F.gw = blockIdx.x * NWAVES + F.wave; F.NGW = F.G * NWAVES;
    volatile LAS unsigned* MISC = (volatile LAS unsigned*)(F.lds + LDS_MISC);
    if (F.tid < 64) MISC[F.tid] = 0u;
    __syncthreads();
    const int lo = args.ph_lo, hi = args.ph_hi;
    XcdBarrier bar; bar.bar = WSP(unsigned, WS_CTL) + 4096; bar.x = 0; bar.st = MISC + 8;
    if (hi - lo > 1) bar = xcd_barrier_post(WSP(unsigned, WS_CTL) + 4096, MISC + 8);
    int ph = 0;
#define PHASE_BEGIN if (lo <= ph && ph < hi) { { int _t = threadIdx.x; asm volatile("" : "+v"(_t)); F.tid = _t; F.lane = _t & 63; }
#define PHASE_END if (ph + 1 < hi) xcd_barrier(bar); } ++ph;

    PHASE_BEGIN for (int rep_ = 0; rep_ < 1 + ((REPM >> 0) & 1); ++rep_) if (!((SKIPM >> 0) & 1)) { prologue_a(F); } PHASE_END
    PHASE_BEGIN for (int rep_ = 0; rep_ < 1 + ((REPM >> 1) & 1); ++rep_) if (!((SKIPM >> 1) & 1)) { prologue_b(F); } PHASE_END

    float* CTXR = WSP(float, WS_CTXR);
#pragma unroll 1
    for (int l = 0; l < NL; ++l) {
        const bool last = (l == NL - 1);
        unsigned char* wl = F.ws + WS_W + (size_t)l * LW_SIZE;
        PHASE_BEGIN for (int rep_ = 0; rep_ < 1 + ((REPM >> 2) & 1); ++rep_) if (!((SKIPM >> 2) & 1)) { norm_phase(F, l == 0 ? F.in[0] : F.out, l == 0 ? F.in[2] : CTXR, F.out, CTXR, l == 0 ? (const bf16_t*)nullptr : WSP(bf16_t, WS_DL), F.in[7] + (size_t)l * D, l, 0, NT,
                CtxWork{l > 0, WSP(bf16_t, WS_A), (const bf16_t*)(wl - LW_SIZE + LW_2B), l > 0 ? modv(F, l - 1, 1, 8) : modv(F, 0, 1, 8), 0.5f, WSP(unsigned, WS_CTL) + 16384 + 64 * (l * 3 + 0)}); } PHASE_END
        PHASE_BEGIN for (int rep_ = 0; rep_ < 1 + ((REPM >> 3) & 1); ++rep_) if (!((SKIPM >> 3) & 1)) { { pg8::Gemm g{WSP(bf16_t, WS_H), (const bf16_t*)(wl + LW_13A), NT, 2 * D, D}; pg8::StaticOrder S; S.init(NT, 2 * D, F.G, (int)blockIdx.x);
            EpiSwiGLU E{WSP(bf16_t, WS_A)}; pg8::gemm_phase<EpiSwiGLU, pg8::StaticOrder, true, true>(F.lds, g, S, E); } } PHASE_END
        PHASE_BEGIN for (int rep_ = 0; rep_ < 1 + ((REPM >> 4) & 1); ++rep_) if (!((SKIPM >> 4) & 1)) { { pg8::Gemm g{WSP(bf16_t, WS_A), (const bf16_t*)(wl + LW_2A), NX, D, D}; pg8::StaticOrder S; S.init(NX, D, F.G, (int)blockIdx.x);
            EpiDelta E{WSP(bf16_t, WS_DL), modv(F, l, 0, 2), modv(F, l, 1, 2), 0.5f}; pg8::gemm_phase<EpiDelta, pg8::StaticOrder, true, true>(F.lds, g, S, E); } } PHASE_END
        PHASE_BEGIN for (int rep_ = 0; rep_ < 1 + ((REPM >> 5) & 1); ++rep_) if (!((SKIPM >> 5) & 1)) { norm_phase(F, l == 0 ? F.in[0] : F.out, l == 0 ? F.in[2] : CTXR, F.out, CTXR, WSP(bf16_t, WS_DL), F.in[11] + (size_t)l * D, l, 3, NT,
                CtxWork{true, WSP(bf16_t, WS_A), (const bf16_t*)(wl + LW_2A), modv(F, l, 1, 2), 0.5f, WSP(unsigned, WS_CTL) + 16384 + 64 * (l * 3 + 1)}); } PHASE_END
        PHASE_BEGIN for (int rep_ = 0; rep_ < 1 + ((REPM >> 6) & 1); ++rep_) if (!((SKIPM >> 6) & 1)) { { pg8::Gemm g{WSP(bf16_t, WS_H), (const bf16_t*)(wl + LW_IN), NT, LDP, D}; pg8::StaticOrder S; S.init(NT, LDP, F.G, (int)blockIdx.x);
            EpiProj E{WSP(bf16_t, WS_P), WSP(float, WS_DT), WSP(float, WS_BIN) + (size_t)l * LDP}; pg8::gemm_phase<EpiProj, pg8::StaticOrder, true, true>(F.lds, g, S, E); } } PHASE_END
        PHASE_BEGIN for (int rep_ = 0; rep_ < 1 + ((REPM >> 7) & 1); ++rep_) if (!((SKIPM >> 7) & 1)) {
            for (int rr = 0; rr < 1 + (REPA & 1); ++rr) conv_all(F, l);
            for (int rr = 0; rr < 1 + ((REPA >> 1) & 1); ++rr) { for (int j = F.NGW - 1 - F.gw; j < NCHK * 8; j += F.NGW) cumsum_job(F, l, j);
            for (int t = (F.NGW - 1 - F.gw) * 4; t < NT; t += F.NGW * 4) vrms_job4(F, t); }
            fft_tables_to_lds(F, WSP(bf16_t, WS_TAB + TAB_CW), WSP(bf16_t, WS_TAB + TAB_SW));
            for (int rr = 0; rr < 1 + ((REPA >> 2) & 1); ++rr) for (int u = blockIdx.x; u < 1024; u += F.G) fft1_unit(F, u >> 6, (u >> 3) & 7, u & 7);
            __syncthreads();
            { const int u = (int)blockIdx.x - (F.G - 8); if (u >= 0 && u < 8) fft1c_unit(F, u); }
        } PHASE_END
        PHASE_BEGIN for (int rep_ = 0; rep_ < 1 + ((REPM >> 8) & 1); ++rep_) if (!((SKIPM >> 8) & 1)) {
            for (int rr = 0; rr < 1 + (REPB & 1); ++rr) {
                for (int u = blockIdx.x; u < 1024; u += F.G) ssd_local_unit4(F, 2 + (u >> 3), (u & 7) * 4);
                for (int u = F.G - 1 - (int)blockIdx.x; u < 16; u += F.G) ssd_local_unit4(F, u >> 3, (u & 7) * 4);
                __syncthreads(); }
            for (int rr = 0; rr < 1 + ((REPB >> 1) & 1); ++rr) for (int u = ((int)blockIdx.x + F.G - 64) % F.G; u < NCHK * 8; u += F.G) sgu_unit(F, l, u >> 3, u & 7);
            fft_tables_to_lds(F, WSP(bf16_t, WS_TAB + TAB_CW), WSP(bf16_t, WS_TAB + TAB_SWN));
            for (int rr = 0; rr < 1 + ((REPB >> 2) & 1); ++rr) for (int u = blockIdx.x; u < 1024; u += F.G) fft2_unit(F, WSP(bf16_t, WS_GPR), WSP(bf16_t, WS_GPI), u >> 3, u & 7, 0, 128, 6.905339660024878e-4f);
            for (int u = ((int)blockIdx.x + F.G - 128) % F.G; u < 16; u += F.G) fft2_unit(F, WSP(bf16_t, WS_GPC), WSP(bf16_t, WS_GPC + MiB), u >> 3, u & 7, NX, 2, 5.524271728019903e-3f);
        } PHASE_END
        PHASE_BEGIN for (int rep_ = 0; rep_ < 1 + ((REPM >> 9) & 1); ++rep_) if (!((SKIPM >> 9) & 1)) { scan_phase(F, last ? 0 : 8);
            if (!last) for (int u = blockIdx.x; u < 8; u += F.G) ssd_out_unit(F, l, u >> 2, u & 3, WSP(bf16_t, WS_SEC) + (size_t)(0 * 2 + (u >> 2)) * 32 * 8192, WSP(bf16_t, WS_SEC) + (size_t)(1 * 2 + (u >> 2)) * 32 * 8192);
            __syncthreads(); } PHASE_END
        PHASE_BEGIN for (int rep_ = 0; rep_ < 1 + ((REPM >> 10) & 1); ++rep_) if (!((SKIPM >> 10) & 1)) {
            for (int u = blockIdx.x; u < 512; u += F.G) { const int ci = 2 + (u >> 2); ssd_out_unit(F, l, ci, u & 3, WSP(bf16_t, WS_SE) + (size_t)(0 * NCHK + ci) * 32 * 8192, WSP(bf16_t, WS_SE) + (size_t)(1 * NCHK + ci) * 32 * 8192); }
            __syncthreads();
        } PHASE_END
        const int Mm = last ? NX : NT;
        PHASE_BEGIN for (int rep_ = 0; rep_ < 1 + ((REPM >> 11) & 1); ++rep_) if (!((SKIPM >> 11) & 1)) { { pg8::Gemm g{WSP(bf16_t, WS_Y), (const bf16_t*)(wl + LW_BR), Mm, D, D}; pg8::StaticOrder S; S.init(Mm, D, F.G, (int)blockIdx.x);
            EpiMerge E{WSP(bf16_t, WS_P), WSP(bf16_t, WS_MG)}; pg8::gemm_phase<EpiMerge, pg8::StaticOrder, true, true>(F.lds, g, S, E); } convert_in_tail(F, l + 1, CV_INP, CV_MRG, ((Mm / 256) * 16) % F.G); } PHASE_END
        PHASE_BEGIN for (int rep_ = 0; rep_ < 1 + ((REPM >> 12) & 1); ++rep_) if (!((SKIPM >> 12) & 1)) { { pg8::Gemm g{WSP(bf16_t, WS_MG), (const bf16_t*)(wl + LW_OUT), NX, D, D}; pg8::StaticOrder S; S.init(NX, D, F.G, (int)blockIdx.x);
            EpiDelta E{WSP(bf16_t, WS_DL), modv(F, l, 0, 5), modv(F, l, 1, 5), 1.0f}; pg8::gemm_phase<EpiDelta, pg8::StaticOrder, true, true>(F.lds, g, S, E); } } PHASE_END
        PHASE_BEGIN for (int rep_ = 0; rep_ < 1 + ((REPM >> 13) & 1); ++rep_) if (!((SKIPM >> 13) & 1)) { norm_phase(F, F.out, CTXR, F.out, CTXR, WSP(bf16_t, WS_DL), F.in[27] + (size_t)l * D, l, 6, Mm,
                CtxWork{!last, WSP(bf16_t, WS_MG), (const bf16_t*)(wl + LW_OUT), modv(F, l, 1, 5), 1.0f, WSP(unsigned, WS_CTL) + 16384 + 64 * (l * 3 + 2)}); } PHASE_END
        PHASE_BEGIN for (int rep_ = 0; rep_ < 1 + ((REPM >> 14) & 1); ++rep_) if (!((SKIPM >> 14) & 1)) { { pg8::Gemm g{WSP(bf16_t, WS_H), (const bf16_t*)(wl + LW_13B), Mm, 2 * D, D}; pg8::StaticOrder S; S.init(Mm, 2 * D, F.G, (int)blockIdx.x);
            EpiSwiGLU E{WSP(bf16_t, WS_A)}; pg8::gemm_phase<EpiSwiGLU, pg8::StaticOrder, true, true>(F.lds, g, S, E); } convert_in_tail(F, l + 1, CV_MRG, IL_ITEMS, ((Mm / 256) * 32) % F.G); } PHASE_END
        PHASE_BEGIN for (int rep_ = 0; rep_ < 1 + ((REPM >> 15) & 1); ++rep_) if (!((SKIPM >> 15) & 1)) { { pg8::Gemm g{WSP(bf16_t, WS_A), (const bf16_t*)(wl + LW_2B), NX, D, D}; pg8::StaticOrder S; S.init(NX, D, F.G, (int)blockIdx.x);
            EpiDelta E{WSP(bf16_t, WS_DL), modv(F, l, 0, 8), modv(F, l, 1, 8), 0.5f}; pg8::gemm_phase<EpiDelta, pg8::StaticOrder, true, true>(F.lds, g, S, E); } } PHASE_END
    }
    PHASE_BEGIN for (int rep_ = 0; rep_ < 1 + ((REPM >> 16) & 1); ++rep_) if (!((SKIPM >> 16) & 1)) { final_norm_phase(F, WSP(bf16_t, WS_DL), F.in[31]); } PHASE_END
#undef PHASE_BEGIN
#undef PHASE_END
}

extern "C" void kernel_launch(void* const* d_in, const int* in_sizes, int n_in, void* d_out, int out_size, void* d_ws, size_t ws_size, hipStream_t stream) {
    static int grid = 0;
    if (grid == 0) {
        if (n_in != 32 || out_size != NX * D || ws_size < WS_END) { fprintf(stderr, "kernel_launch: unexpected shapes (n_in %d, out %d, ws %zu < %zu)\n", n_in, out_size, ws_size, (size_t)WS_END); grid = -1; return; }
        int dev = 0, cus = 0;
        if (hipGetDevice(&dev) != hipSuccess || hipDeviceGetAttribute(&cus, hipDeviceAttributeMultiprocessorCount, dev) != hipSuccess) { grid = -1; return; }
        if (hipFuncSetAttribute((const void*)trunk_fwd, hipFuncAttributeMaxDynamicSharedMemorySize, LDS_BYTES) != hipSuccess) { fprintf(stderr, "kernel_launch: hipFuncSetAttribute failed\n"); grid = -1; return; }
        int per_cu = 0;
        if (hipOccupancyMaxActiveBlocksPerMultiprocessor(&per_cu, (const void*)trunk_fwd, NTHR, LDS_BYTES) != hipSuccess || per_cu < 1) { fprintf(stderr, "kernel_launch: occupancy query says %d\n", per_cu); }
        (void)hipGetLastError();
        grid = cus;
    }
    if (grid < 0) return;
    (void)in_sizes;
    hipMemsetAsync((char*)d_ws + WS_CTL, 0, MiB, stream);
    Args a{};
    for (int i = 0; i < 32; ++i) a.in[i] = (const float*)d_in[i];
    a.out = (float*)d_out; a.ws = (unsigned char*)d_ws;
#if MK_SPLIT
    for (int p = 0; p < N_PHASES; ++p) { a.ph_lo = p; a.ph_hi = p + 1; hipLaunchKernelGGL(trunk_fwd, dim3(grid), dim3(NTHR), LDS_BYTES, stream, a); }
#else
    a.ph_lo = 0; a.ph_hi = N_PHASES;
    hipLaunchKernelGGL(trunk_fwd, dim3(grid), dim3(NTHR), LDS_BYTES, stream, a);
#endif
}
```

```cpp
#include <hip/hip_runtime.h>
#include <cstdio>
#include <cstdint>

#ifndef MK_SPLIT
#define MK_SPLIT 0
#endif

namespace pg8 {
#define PG8_LAS __attribute__((address_space(3)))
typedef unsigned short bf16_t;
typedef short bf16x8 __attribute__((ext_vector_type(8)));
typedef float f32x4 __attribute__((ext_vector_type(4)));
typedef unsigned u32x4 __attribute__((ext_vector_type(4)));
constexpr int BM = 256, BK = 64, HALF = 128, HTB = HALF * BK * 2  , STAGE_BYTES = 8 * HTB, NXCD = 8, WGM = 8;

__host__ __device__ __forceinline__ int lds_byte(int r, int c) { const int st = (r >> 4) * 2 + (c >> 5), rr = r & 15, cc = c & 31, ob = rr * 64 + cc * 2; return st * 1024 + (ob ^ (((ob >> 9) & 1) << 5)); }
__host__ __device__ __forceinline__ void stage_rc(int b, int& R, int& C) { const int st = b / 1024, sb = b % 1024, swz = sb ^ (((sb >> 9) & 1) << 5); R = (st >> 1) * 16 + swz / 64; C = (st & 1) * 32 + (swz % 64) / 2; }
__host__ __device__ __forceinline__ int perm32(int rho) { const int n = rho >> 4, i = rho & 15; return 8 * (i >> 2) + 4 * n + (i & 3); }

struct Unit { int pm, pn; };
struct Gemm { const bf16_t* A; const bf16_t* Bt; int M, N, K; int ld = 0; };

struct StaticOrder {
    int nM, nN, nwg, G, c;
    __host__ __device__ void init(int M, int N, int G_, int c_) { nM = M / BM; nN = N / BM; nwg = nM * nN; G = G_; c = c_; }
    __host__ __device__ bool next(int i, Unit& u) const {
        const long L = (long)i * G + c; if (L >= nwg) return false;
        int wgid = (int)L; { const int q = nwg / NXCD, r = nwg % NXCD, xcd = wgid % NXCD, off = wgid / NXCD; wgid = (xcd < r ? xcd * (q + 1) : r * (q + 1) + (xcd - r) * q) + off; }
        const int nig = WGM * nN, gid = wgid / nig, fm = gid * WGM, gsz = (nM - fm) < WGM ? (nM - fm) : WGM;
        u.pm = fm + ((wgid % nig) % gsz); u.pn = (wgid % nig) / gsz; return true;
    }
    __device__ __forceinline__ void a_ready(const Unit&) const {}
    __device__ __forceinline__ void done(const Unit&) const {}
};
template <class Epi, class Sched, bool ALIGN_EPI = false, bool SP2 = false>
__device__ __forceinline__ void gemm_phase(PG8_LAS unsigned char* lds, const Gemm g, const Sched& S, const Epi& E) {
    int tid_ = threadIdx.x; asm volatile("" : "+v"(tid_));   const int tid = tid_, wid = __builtin_amdgcn_readfirstlane(tid >> 6), lane = tid & 63, wr = wid >> 2, wc = wid & 3, fr = lane & 15, fq = lane >> 4;
    const int K = g.K, nt = K / BK, LD = g.ld ? g.ld : g.K;
    unsigned voffA[2], voffB[2];
#pragma unroll
    for (int i = 0; i < 2; ++i) { int R, C; stage_rc(tid * 16 + i * 8192, R, C); const int Rb = Epi::PERM ? ((R & ~31) + perm32(R & 31)) : R;
        voffA[i] = (unsigned)(R * LD + C) * 2u; voffB[i] = (unsigned)(Rb * LD + C) * 2u; }
    const size_t kstep = (size_t)(BK * 2);
    const size_t hstep = (size_t)HALF * LD * 2;
    const size_t tstep = 2 * hstep;
    const unsigned ldsw = (unsigned)wid * 1024u;
    const int aoff = lds_byte(wr * 64 + fr, fq * 8), boff = lds_byte(wc * 32 + fr, fq * 8);
#define PG8_SA(b, h) (((b) * 2 + (h)) * HTB)
#define PG8_SB(b, h) ((4 + (b) * 2 + (h)) * HTB)
#define PG8_STAGE(bufoff, gbase, voff) do { _Pragma("unroll") for (int _i = 0; _i < 2; ++_i) \
        __builtin_amdgcn_global_load_lds((const unsigned*)((const char*)(gbase) + (voff)[_i]), (PG8_LAS unsigned*)(lds + (bufoff) + ldsw + _i * 8192), 16, 0, 0); } while (0)
#define PG8_LDA(dst, b, h) do { _Pragma("unroll") for (int m = 0; m < 4; ++m) _Pragma("unroll") for (int k = 0; k < 2; ++k) dst[m][k] = *(const PG8_LAS bf16x8*)(lds + PG8_SA(b, h) + aoff + m * 2048 + k * 1024); } while (0)
#define PG8_LDB(dst, b, h) do { _Pragma("unroll") for (int n = 0; n < 2; ++n) _Pragma("unroll") for (int k = 0; k < 2; ++k) dst[n][k] = *(const PG8_LAS bf16x8*)(lds + PG8_SB(b, h) + boff + n * 2048 + k * 1024); } while (0)
#define PG8_MMA(ai, bj, At, Bt) do { __builtin_amdgcn_s_setprio(1); _Pragma("unroll") for (int m = 0; m < 4; ++m) _Pragma("unroll") for (int n = 0; n < 2; ++n) _Pragma("unroll") for (int k = 0; k < 2; ++k) \
        acc[ai][bj][m][n] = __builtin_amdgcn_mfma_f32_16x16x32_bf16(Bt[n][k], At[m][k], acc[ai][bj][m][n], 0, 0, 0); __builtin_amdgcn_s_setprio(0); } while (0)
#define PG8_WAIT_V(n) asm volatile("s_waitcnt vmcnt(" #n ")" ::: "memory")
#define PG8_WAIT_L(n) asm volatile("s_waitcnt lgkmcnt(" #n ")" ::: "memory")
#define PG8_BAR __builtin_amdgcn_s_barrier()
#define PG8_SCHED __builtin_amdgcn_sched_barrier(0)
    Unit cur, nxt; int ui = 0;
    if (!S.next(0, cur)) return;
    f32x4 acc[2][2][4][2];
#pragma unroll
    for (int a = 0; a < 2; ++a)
#pragma unroll
        for (int b = 0; b < 2; ++b)
#pragma unroll
            for (int m = 0; m < 4; ++m)
#pragma unroll
                for (int n = 0; n < 2; ++n) acc[a][b][m][n] = (f32x4){0.f, 0.f, 0.f, 0.f};
    bf16x8 At[4][2], B0[2][2], B1[2][2];
    typename Epi::Pre pre; E.pre_init(pre);
    const char* cA = (const char*)g.A + (size_t)cur.pm * tstep; const char* cB = (const char*)g.Bt + (size_t)cur.pn * tstep;
    S.a_ready(cur);
    if constexpr (SP2) {
        PG8_STAGE(PG8_SB(0, 0), cB, voffB); PG8_STAGE(PG8_SB(0, 1), cB + hstep, voffB); PG8_STAGE(PG8_SA(0, 0), cA, voffA); PG8_STAGE(PG8_SA(0, 1), cA + hstep, voffA);
        if (wr == 1) PG8_BAR;
        PG8_WAIT_V(2); PG8_BAR;
        PG8_STAGE(PG8_SB(1, 0), cB + kstep, voffB); PG8_STAGE(PG8_SA(1, 0), cA + kstep, voffA); PG8_STAGE(PG8_SB(1, 1), cB + hstep + kstep, voffB);
        PG8_WAIT_V(6); PG8_BAR;
    } else {
        PG8_STAGE(PG8_SB(0, 0), cB, voffB); PG8_STAGE(PG8_SA(0, 0), cA, voffA); PG8_STAGE(PG8_SB(0, 1), cB + hstep, voffB); PG8_STAGE(PG8_SA(0, 1), cA + hstep, voffA);
        if (wr == 1) PG8_BAR;
        PG8_WAIT_V(4); PG8_BAR;
        PG8_STAGE(PG8_SB(1, 0), cB + kstep, voffB); PG8_STAGE(PG8_SA(1, 0), cA + kstep, voffA); PG8_STAGE(PG8_SB(1, 1), cB + hstep + kstep, voffB);
        PG8_WAIT_V(6); PG8_BAR;
    }
    for (;;) {
        const bool has_next = S.next(ui + 1, nxt);
        const char* nA = has_next ? (const char*)g.A + (size_t)nxt.pm * tstep : cA; const char* nB = has_next ? (const char*)g.Bt + (size_t)nxt.pn * tstep : cB;
        for (int t = 0; t < nt; t += 2) {
            const bool last = (t == nt - 2);
            const char* a1 = cA + (size_t)(t + 1) * kstep;
            const char* a2 = last ? nA : cA + (size_t)(t + 2) * kstep; const char* b2 = last ? nB : cB + (size_t)(t + 2) * kstep;
            const char* a3 = a2 + kstep; const char* b3 = b2 + kstep;
            if (last && has_next) S.a_ready(nxt);
            if (last) E.prefetch(pre, cur, wr, wc, fr, fq);
            if constexpr (Epi::KHOOK) { if (t == Epi::H1 || t == Epi::H2) E.khook(acc, cur, t, wr, wc, fr, fq); }
            if constexpr (SP2) {
            PG8_LDB(B0, 0, 0); PG8_LDB(B1, 0, 1); PG8_SCHED; PG8_LDA(At, 0, 0); PG8_STAGE(PG8_SA(1, 1), a1 + hstep, voffA);
            PG8_WAIT_V(8); PG8_WAIT_L(0); PG8_BAR; PG8_MMA(0, 0, At, B0); PG8_MMA(0, 1, At, B1); PG8_BAR; PG8_SCHED;
            PG8_LDA(At, 0, 1); PG8_STAGE(PG8_SB(0, 0), b2, voffB); PG8_STAGE(PG8_SB(0, 1), b2 + hstep, voffB); PG8_STAGE(PG8_SA(0, 0), a2, voffA);
            PG8_WAIT_V(8); PG8_WAIT_L(0); PG8_BAR; PG8_MMA(1, 0, At, B0); PG8_MMA(1, 1, At, B1); PG8_BAR; PG8_SCHED;
            PG8_LDB(B0, 1, 0); PG8_LDB(B1, 1, 1); PG8_SCHED; PG8_LDA(At, 1, 0); PG8_STAGE(PG8_SA(0, 1), a2 + hstep, voffA);
            PG8_WAIT_V(8); PG8_WAIT_L(0); PG8_BAR; PG8_MMA(0, 0, At, B0); PG8_MMA(0, 1, At, B1); PG8_BAR; PG8_SCHED;
            PG8_LDA(At, 1, 1); PG8_STAGE(PG8_SB(1, 0), b3, voffB); PG8_STAGE(PG8_SB(1, 1), b3 + hstep, voffB); PG8_STAGE(PG8_SA(1, 0), a3, voffA);
            PG8_WAIT_V(8); PG8_WAIT_L(0); PG8_BAR; PG8_MMA(1, 0, At, B0); PG8_MMA(1, 1, At, B1); PG8_BAR; PG8_SCHED;
            } else {
            PG8_LDB(B0, 0, 0); PG8_SCHED; PG8_LDA(At, 0, 0); PG8_STAGE(PG8_SA(1, 1), a1 + hstep, voffA);
            PG8_WAIT_L(8); PG8_BAR; PG8_WAIT_L(0); PG8_MMA(0, 0, At, B0); PG8_BAR; PG8_SCHED;
            PG8_LDB(B1, 0, 1); PG8_STAGE(PG8_SB(0, 0), b2, voffB);
            PG8_BAR; PG8_WAIT_L(0); PG8_MMA(0, 1, At, B1); PG8_BAR;
            PG8_LDA(At, 0, 1); PG8_STAGE(PG8_SA(0, 0), a2, voffA);
            PG8_BAR; PG8_WAIT_L(0); PG8_MMA(1, 0, At, B0); PG8_BAR; PG8_SCHED;
            PG8_STAGE(PG8_SB(0, 1), b2 + hstep, voffB);
            PG8_WAIT_V(6); PG8_BAR; PG8_MMA(1, 1, At, B1); PG8_BAR;
            PG8_LDB(B0, 1, 0); PG8_SCHED; PG8_LDA(At, 1, 0); PG8_STAGE(PG8_SA(0, 1), a2 + hstep, voffA);
            PG8_WAIT_L(8); PG8_BAR; PG8_WAIT_L(0); PG8_MMA(0, 0, At, B0); PG8_BAR; PG8_SCHED;
            PG8_LDB(B1, 1, 1); PG8_STAGE(PG8_SB(1, 0), b3, voffB);
            PG8_BAR; PG8_WAIT_L(0); PG8_MMA(0, 1, At, B1); PG8_BAR;
            PG8_LDA(At, 1, 1); PG8_STAGE(PG8_SA(1, 0), a3, voffA);
            PG8_BAR; PG8_WAIT_L(0); PG8_MMA(1, 0, At, B0); PG8_BAR; PG8_SCHED;
            PG8_STAGE(PG8_SB(1, 1), b3 + hstep, voffB);
            PG8_WAIT_V(6); PG8_BAR; PG8_MMA(1, 1, At, B1); PG8_BAR;
            }
        }
        if constexpr (ALIGN_EPI) { if (wr == 0) PG8_BAR; }
        if constexpr (!Epi::AFTER_DRAIN) { E(acc, cur, wr, wc, fr, fq, pre); S.done(cur); }
        if (!has_next) break;
#pragma unroll
        for (int a = 0; a < 2; ++a)
#pragma unroll
            for (int b = 0; b < 2; ++b)
#pragma unroll
                for (int m = 0; m < 4; ++m)
#pragma unroll
                    for (int n = 0; n < 2; ++n) acc[a][b][m][n] = (f32x4){0.f, 0.f, 0.f, 0.f};
        cur = nxt; cA = nA; cB = nB; ++ui;
        if constexpr (ALIGN_EPI) { if (wr == 1) PG8_BAR; }
    }
    PG8_WAIT_V(0);
    if constexpr (!ALIGN_EPI) { if (wr == 0) PG8_BAR; }
    PG8_BAR;
    if constexpr (Epi::AFTER_DRAIN) { E.fused(acc, cur, wr, wc, fr, fq, lds, wid, lane); S.done(cur); }
#undef PG8_SA
#undef PG8_SB
#undef PG8_STAGE
#undef PG8_LDA
#undef PG8_LDB
#undef PG8_MMA
#undef PG8_WAIT_V
#undef PG8_WAIT_L
#undef PG8_BAR
#undef PG8_SCHED
}
}

constexpr int D = 4096, NX = 16384, NCX = 256, NT = NX + NCX, NL = 4;
constexpr int NCHK = 130;
constexpr int LDP = 20736;
constexpr int PZ = 0, PXBC = 2048, PU = 5120, PV = 6144, PF = 7168, PG = 8192, PDT = 20480;
constexpr float EPS = 1e-6f;
constexpr int NWAVES = 8, NTHR = 512;
#ifndef KHOOK_ON
#define KHOOK_ON true
#endif

constexpr size_t MiB = 1u << 20;
constexpr size_t WS_CTL = 0;
constexpr size_t WS_MOD = 1 * MiB;
constexpr size_t WS_T1 = 3 * MiB;
constexpr size_t WS_BIN = 4 * MiB;
constexpr size_t WS_TAB = 5 * MiB;
constexpr size_t TAB_CW = 0, TAB_SW = 32768, TAB_SWN = 65536, TAB_TW = 98304, TAB_TWC = 98304 + 131072;
constexpr size_t WS_SGW = 6 * MiB;
constexpr size_t WS_DT = 7 * MiB;
constexpr size_t WS_CS = 12 * MiB;
constexpr size_t WS_EIN = 17 * MiB;
constexpr size_t WS_WEND = 22 * MiB;
constexpr size_t WS_TOT = 27 * MiB;
constexpr size_t WS_RINV = 27 * MiB + 256 * 1024;
constexpr size_t WS_CTXR = 27 * MiB + 512 * 1024;
constexpr size_t WS_SEC = 31 * MiB + 512 * 1024;
constexpr size_t WS_GPC = 33 * MiB + 512 * 1024;
constexpr size_t WS_W = 36 * MiB;
constexpr size_t LW_13A = 0, LW_2A = 64 * MiB, LW_IN = 96 * MiB, LW_BR = 258 * MiB, LW_OUT = 290 * MiB, LW_13B = 322 * MiB, LW_2B = 386 * MiB, LW_SIZE = 418 * MiB;
constexpr size_t WS_H = WS_W + NL * LW_SIZE;
constexpr size_t WS_A = WS_H + 130 * MiB;
constexpr size_t WS_P = WS_A + 130 * MiB;
constexpr size_t WS_XC = WS_P + 659 * MiB;
constexpr size_t WS_XT = WS_XC + 98 * MiB;
constexpr size_t WS_Y = WS_XT + 82 * MiB;
constexpr size_t WS_MG = WS_Y + 130 * MiB;
constexpr size_t WS_LS = WS_MG + 130 * MiB;
constexpr size_t WS_SE = WS_LS + 260 * MiB;
constexpr size_t WS_GPR = WS_SE + 130 * MiB;
constexpr size_t WS_GPI = WS_GPR + 32 * MiB;
constexpr size_t WS_DL = WS_GPI + 32 * MiB;
constexpr size_t WS_DL2 = WS_DL + 130 * MiB;
constexpr size_t WS_END = WS_DL2 + 130 * MiB;
static_assert((size_t)NT * LDP * 2 <= 659 * MiB && (size_t)20736 * 4096 * 2 == 162 * MiB, "map");

constexpr int LDS_BYTES = 155648;
constexpr int LDS_MISC = 151552;

#define LAS __attribute__((address_space(3)))
typedef unsigned short bf16_t;
typedef short v8s __attribute__((ext_vector_type(8)));
typedef short v4s __attribute__((ext_vector_type(4)));
typedef _Float16 v8h __attribute__((ext_vector_type(8)));
typedef _Float16 v2h __attribute__((ext_vector_type(2)));
typedef float f32x4 __attribute__((ext_vector_type(4)));
typedef float f32x2 __attribute__((ext_vector_type(2)));
typedef unsigned u32x4 __attribute__((ext_vector_type(4)));
typedef unsigned u32x2 __attribute__((ext_vector_type(2)));

__device__ __forceinline__ unsigned cvt_pk_bf16(float lo, float hi) { unsigned r; asm volatile("v_cvt_pk_bf16_f32 %0, %1, %2" : "=v"(r) : "v"(lo), "v"(hi)); return r; }
__device__ __forceinline__ float bf_lo(unsigned u) { return __uint_as_float(u << 16); }
__device__ __forceinline__ float bf_hi(unsigned u) { return __uint_as_float(u & 0xffff0000u); }
__device__ __forceinline__ float bf1(bf16_t b) { return __uint_as_float(((unsigned)b) << 16); }
__device__ __forceinline__ bf16_t f2bf(float f) { return (bf16_t)(cvt_pk_bf16(f, 0.f) & 0xffffu); }
__device__ __forceinline__ unsigned pk_f16(float a, float b) { v2h v = {(_Float16)a, (_Float16)b}; return __builtin_bit_cast(unsigned, v); }
__device__ __forceinline__ bf16_t f2h(float a) { _Float16 h = (_Float16)a; return __builtin_bit_cast(unsigned short, h); }
__device__ __forceinline__ f32x4 mma_bf(v8s a, v8s b, f32x4 c) { return __builtin_amdgcn_mfma_f32_16x16x32_bf16(a, b, c, 0, 0, 0); }
__device__ __forceinline__ f32x4 mma_h(v8s a, v8s b, f32x4 c) { return __builtin_amdgcn_mfma_f32_16x16x32_f16(__builtin_bit_cast(v8h, a), __builtin_bit_cast(v8h, b), c, 0, 0, 0); }
__device__ __forceinline__ v8s ld16(const bf16_t* p) { return *(const v8s*)p; }
__device__ __forceinline__ v8s ld8x2(const bf16_t* p0, const bf16_t* p1) { const v4s a = *(const v4s*)p0, b = *(const v4s*)p1; return __builtin_shufflevector(a, b, 0, 1, 2, 3, 4, 5, 6, 7); }
__device__ __forceinline__ v8s pack8_bf(float e0, float e1, float e2, float e3, float e4, float e5, float e6, float e7) {
    u32x4 w; w.x = cvt_pk_bf16(e0, e1); w.y = cvt_pk_bf16(e2, e3); w.z = cvt_pk_bf16(e4, e5); w.w = cvt_pk_bf16(e6, e7); return __builtin_bit_cast(v8s, w); }
__device__ __forceinline__ v8s pack8_h(float e0, float e1, float e2, float e3, float e4, float e5, float e6, float e7) {
    u32x4 w; w.x = pk_f16(e0, e1); w.y = pk_f16(e2, e3); w.z = pk_f16(e4, e5); w.w = pk_f16(e6, e7); return __builtin_bit_cast(v8s, w); }
__device__ __forceinline__ float wave_sum(float v) {
#pragma unroll
    for (int o = 1; o < 64; o <<= 1) v += __shfl_xor(v, o);
    return v;
}
__device__ __forceinline__ float silu_f(float x) { return x * __builtin_amdgcn_rcpf(1.0f + __expf(-x)); }
__device__ __forceinline__ float sigm_f(float x) { return __builtin_amdgcn_rcpf(1.0f + __expf(-x)); }
__device__ __forceinline__ float gelu_f(float x) { const float u = 0.7978845608028654f * (x + 0.044715f * x * x * x); return x * __builtin_amdgcn_rcpf(1.0f + __expf(-2.0f * u)); }
__device__ __forceinline__ float softplus_f(float x) { return fmaxf(x, 0.f) + log1pf(expf(-fabsf(x))); }
__device__ __forceinline__ int chunk_t0(int ci) { return ci < 2 ? NX + 128 * ci : 128 * (ci - 2); }
#define LDS_WAIT() asm volatile("s_waitcnt lgkmcnt(0)" ::: "memory")
#define LDS_BAR() do { asm volatile("s_waitcnt lgkmcnt(0)" ::: "memory"); __builtin_amdgcn_s_barrier(); asm volatile("" ::: "memory"); } while (0)

#define XB_TMO      128
#define XB_XCNT(j)  (256  + 64 * (j))
#define XB_XSUB(j)  (1280 + 64 * (j))
#define XB_XGEN(j)  (2304 + 64 * (j))
#define XB_TOP      3328
#define XB_TOPGEN   3392
#define XCD_BAR_WORDS 3456
#define XB_SPIN_CAP (1u << 18)
__device__ __forceinline__ unsigned xb_ld(unsigned* p)              { return __hip_atomic_load(p, __ATOMIC_RELAXED, __HIP_MEMORY_SCOPE_AGENT); }
__device__ __forceinline__ unsigned xb_add(unsigned* p, unsigned v) { return __hip_atomic_fetch_add(p, v, __ATOMIC_RELAXED, __HIP_MEMORY_SCOPE_AGENT); }
__device__ __forceinline__ unsigned xb_xcc_id() { return (unsigned)__builtin_amdgcn_s_getreg((3 << 11) | 20) & 0xFu; }
#define XB_SPIN(cond, bar) do { unsigned _sp = 0; while (cond) { __builtin_amdgcn_s_sleep(1); \
    if ((++_sp & 255u) == 0u) { if (xb_ld(&(bar)[XB_TMO])) break; if (_sp > XB_SPIN_CAP) { atomicAdd(&(bar)[XB_TMO], 1u); break; } } } } while (0)
struct XcdBarrier { unsigned* bar; unsigned x; volatile LAS unsigned* st; };
__device__ __forceinline__ XcdBarrier xcd_barrier_post(unsigned* bar, volatile LAS unsigned* st) {
    XcdBarrier b; b.bar = bar; b.x = xb_xcc_id(); b.st = st;
    if (threadIdx.x == 0) (void)xb_add(&bar[XB_XCNT(b.x)], 1u);
    return b;
}
__device__ __forceinline__ void xcd_barrier_complete(unsigned* bar, unsigned x, unsigned& nloc, unsigned& nx) {
    const unsigned G = gridDim.x * gridDim.y * gridDim.z;
    unsigned sum, cnt, mine, sp = 0u;
    for (;;) {
        sum = 0u; cnt = 0u; mine = 0u;
#pragma unroll
        for (unsigned j = 0; j < 16; ++j) { const unsigned c = xb_ld(&bar[XB_XCNT(j)]); sum += c; cnt += (c > 0u) ? 1u : 0u; mine = (j == x) ? c : mine; }
        if (sum == G) break;
        __builtin_amdgcn_s_sleep(1);
        if ((++sp & 255u) == 0u) { if (xb_ld(&bar[XB_TMO])) break; if (sp > XB_SPIN_CAP) { atomicAdd(&bar[XB_TMO], 1u); break; } }
    }
    nloc = mine > 0u ? mine : 1u; nx = cnt > 0u ? cnt : 1u;
}
__device__ __forceinline__ void xcd_barrier(const XcdBarrier& b) {
    asm volatile("s_waitcnt vmcnt(0)" ::: "memory");
    __syncthreads();
    if (threadIdx.x == 0) {
        unsigned* bar = b.bar;
        __builtin_amdgcn_s_waitcnt(0);
        unsigned nloc = b.st[0], nx = b.st[1];
        if (nloc == 0u) { xcd_barrier_complete(bar, b.x, nloc, nx); b.st[0] = nloc; b.st[1] = nx; }
        const unsigned old = xb_add(&bar[XB_XSUB(b.x)], 1u);
        const unsigned gen = old / nloc;
        if (old + 1u == (gen + 1u) * nloc) {
            __builtin_amdgcn_fence(__ATOMIC_RELEASE, "agent");
            asm volatile("s_waitcnt vmcnt(0)" ::: "memory");
            const unsigned og = xb_add(&bar[XB_TOP], 1u);
            const unsigned tg = og / nx;
            if (og + 1u == (tg + 1u) * nx) xb_add(&bar[XB_TOPGEN], 1u);
            else XB_SPIN(xb_ld(&bar[XB_TOPGEN]) == tg, bar);
            __builtin_amdgcn_fence(__ATOMIC_ACQUIRE, "agent");
            xb_add(&bar[XB_XGEN(b.x)], 1u);
            asm volatile("s_waitcnt vmcnt(0)" ::: "memory");
        } else {
            XB_SPIN(xb_ld(&bar[XB_XGEN(b.x)]) == gen, bar);
            __builtin_amdgcn_fence(__ATOMIC_ACQUIRE, "agent");
            asm volatile("s_waitcnt vmcnt(0)" ::: "memory");
        }
    }
    __syncthreads();
}

struct Frame {
    LAS unsigned char* lds;
    unsigned char* ws;
    const float* const* in;
    float* out;
    int tid, lane, wave, G, gw, NGW;
};
#define WSP(T, off) ((T*)(F.ws + (off)))

using pg8::Unit;
struct EpiSwiGLU {
    static constexpr bool PERM = true, AFTER_DRAIN = false, KHOOK = false; static constexpr int H1 = -1, H2 = -1;
    bf16_t* O;
    struct Pre {};
    __device__ __forceinline__ void pre_init(Pre&) const {}
    __device__ __forceinline__ void prefetch(Pre&, const Unit&, int, int, int, int) const {}
    __device__ __forceinline__ void khook(f32x4 (&)[2][2][4][2], const Unit&, int, int, int, int, int) const {}
    __device__ __forceinline__ void operator()(const f32x4 (&acc)[2][2][4][2], const Unit& u, int wr, int wc, int fr, int fq, const Pre&) const {
        const int row0 = u.pm * 256 + wr * 64 + fr, col0 = u.pn * 128 + wc * 32 + 8 * fq;
#pragma unroll
        for (int ai = 0; ai < 2; ++ai)
#pragma unroll
            for (int m = 0; m < 4; ++m) {
                float o[8];
#pragma unroll
                for (int n = 0; n < 2; ++n)
#pragma unroll
                    for (int j = 0; j < 4; ++j) o[4 * n + j] = silu_f(acc[ai][0][m][n][j]) * acc[ai][1][m][n][j];
                u32x4 w; w.x = cvt_pk_bf16(o[0], o[1]); w.y = cvt_pk_bf16(o[2], o[3]); w.z = cvt_pk_bf16(o[4], o[5]); w.w = cvt_pk_bf16(o[6], o[7]);
                *(u32x4*)(O + (size_t)(row0 + ai * 128 + m * 16) * D + col0) = w;
            }
    }
};
struct EpiDelta {
    static constexpr bool PERM = true, AFTER_DRAIN = false, KHOOK = false; static constexpr int H1 = -1, H2 = -1;
    bf16_t* O; const float* coefx; const float* coefc; float scale;
    struct Pre { f32x4 cv[2][2]; };
    __device__ __forceinline__ void pre_init(Pre& p) const {
#pragma unroll
        for (int bj = 0; bj < 2; ++bj)
#pragma unroll
            for (int n = 0; n < 2; ++n) p.cv[bj][n] = (f32x4){0.f, 0.f, 0.f, 0.f}; }
    __device__ __forceinline__ void prefetch(Pre& p, const Unit& u, int wr, int wc, int fr, int fq) const {
        const float* coef = (u.pm == 64 ? coefc : coefx) + u.pn * 256 + wc * 32 + 8 * fq;
#pragma unroll
        for (int bj = 0; bj < 2; ++bj)
#pragma unroll
            for (int n = 0; n < 2; ++n) p.cv[bj][n] = *(const f32x4*)(coef + bj * 128 + 4 * n) * scale; }
    __device__ __forceinline__ void khook(f32x4 (&)[2][2][4][2], const Unit&, int, int, int, int, int) const {}
    __device__ __forceinline__ void operator()(const f32x4 (&acc)[2][2][4][2], const Unit& u, int wr, int wc, int fr, int fq, const Pre& p) const {
        const int row0 = u.pm * 256 + wr * 64 + fr, col0 = u.pn * 256 + wc * 32 + 8 * fq;
#pragma unroll
        for (int ai = 0; ai < 2; ++ai)
#pragma unroll
            for (int m = 0; m < 4; ++m) { bf16_t* rowp = O + (size_t)(row0 + ai * 128 + m * 16) * D + col0;
#pragma unroll
                for (int bj = 0; bj < 2; ++bj) { const f32x4 v0 = acc[ai][bj][m][0] * p.cv[bj][0], v1 = acc[ai][bj][m][1] * p.cv[bj][1]; u32x4 w;
                    w.x = cvt_pk_bf16(v0[0], v0[1]); w.y = cvt_pk_bf16(v0[2], v0[3]); w.z = cvt_pk_bf16(v1[0], v1[1]); w.w = cvt_pk_bf16(v1[2], v1[3]);
                    *(u32x4*)(rowp + bj * 128) = w; } }
    }
};
struct EpiProj {
    static constexpr bool PERM = true, AFTER_DRAIN = false, KHOOK = false; static constexpr int H1 = -1, H2 = -1;
    bf16_t* P; float* DT; const float* bias;
    struct Pre { f32x4 bv[2][2]; };
    __device__ __forceinline__ void pre_init(Pre& p) const {
#pragma unroll
        for (int bj = 0; bj < 2; ++bj)
#pragma unroll
            for (int n = 0; n < 2; ++n) p.bv[bj][n] = (f32x4){0.f, 0.f, 0.f, 0.f}; }
    __device__ __forceinline__ void prefetch(Pre& p, const Unit& u, int wr, int wc, int fr, int fq) const {
        const float* b = bias + u.pn * 256 + wc * 32 + 8 * fq;
#pragma unroll
        for (int bj = 0; bj < 2; ++bj)
#pragma unroll
            for (int n = 0; n < 2; ++n) p.bv[bj][n] = *(const f32x4*)(b + bj * 128 + 4 * n); }
    __device__ __forceinline__ void khook(f32x4 (&)[2][2][4][2], const Unit&, int, int, int, int, int) const {}
    __device__ __forceinline__ void operator()(const f32x4 (&acc)[2][2][4][2], const Unit& u, int wr, int wc, int fr, int fq, const Pre& p) const {
        const int row0 = u.pm * 256 + wr * 64 + fr, col0 = u.pn * 256 + wc * 32 + 8 * fq;
        const int pn = u.pn;
        if (pn == 80) {
            if (wc < 2) {
#pragma unroll
                for (int ai = 0; ai < 2; ++ai)
#pragma unroll
                    for (int m = 0; m < 4; ++m) { float* rowp = DT + (size_t)(row0 + ai * 128 + m * 16) * 64 + wc * 32 + 8 * fq;
#pragma unroll
                        for (int n = 0; n < 2; ++n) { const f32x4 v = acc[ai][0][m][n] + p.bv[0][n]; f32x4 o;
#pragma unroll
                            for (int j = 0; j < 4; ++j) o[j] = softplus_f(v[j]);
                            *(f32x4*)(rowp + 4 * n) = o; } }
            }
            return;
        }
        const bool raw = (pn >= 8 && pn < 20) || (pn >= 28 && pn < 32), f16o = (pn >= 28 && pn < 32);
        if (raw) {
#pragma unroll
            for (int ai = 0; ai < 2; ++ai)
#pragma unroll
                for (int m = 0; m < 4; ++m) { bf16_t* rowp = P + (size_t)(row0 + ai * 128 + m * 16) * LDP + col0;
#pragma unroll
                    for (int bj = 0; bj < 2; ++bj) { const f32x4 v0 = acc[ai][bj][m][0] + p.bv[bj][0], v1 = acc[ai][bj][m][1] + p.bv[bj][1]; u32x4 w;
                        if (f16o) { w.x = pk_f16(v0[0], v0[1]); w.y = pk_f16(v0[2], v0[3]); w.z = pk_f16(v1[0], v1[1]); w.w = pk_f16(v1[2], v1[3]); }
                        else { w.x = cvt_pk_bf16(v0[0], v0[1]); w.y = cvt_pk_bf16(v0[2], v0[3]); w.z = cvt_pk_bf16(v1[0], v1[1]); w.w = cvt_pk_bf16(v1[2], v1[3]); }
                        *(u32x4*)(rowp + bj * 128) = w; } }
            return;
        }
        constexpr float NL2E = -1.4426950408889634f;
        if (pn >= 32) {
            f32x4 nb[2][2];
#pragma unroll
            for (int bj = 0; bj < 2; ++bj)
#pragma unroll
                for (int n = 0; n < 2; ++n) nb[bj][n] = p.bv[bj][n] * NL2E;
#pragma unroll
            for (int ai = 0; ai < 2; ++ai)
#pragma unroll
                for (int m = 0; m < 4; ++m) { bf16_t* rowp = P + (size_t)(row0 + ai * 128 + m * 16) * LDP + col0;
#pragma unroll
                    for (int bj = 0; bj < 2; ++bj) { f32x4 v0 = acc[ai][bj][m][0] * NL2E + nb[bj][0], v1 = acc[ai][bj][m][1] * NL2E + nb[bj][1]; u32x4 w;
#pragma unroll
                        for (int j = 0; j < 4; ++j) { v0[j] = __builtin_amdgcn_exp2f(v0[j]); v1[j] = __builtin_amdgcn_exp2f(v1[j]); }
                        v0 = v0 + 1.0f; v1 = v1 + 1.0f;
#pragma unroll
                        for (int j = 0; j < 4; ++j) { v0[j] = __builtin_amdgcn_rcpf(v0[j]); v1[j] = __builtin_amdgcn_rcpf(v1[j]); }
                        w.x = cvt_pk_bf16(v0[0], v0[1]); w.y = cvt_pk_bf16(v0[2], v0[3]); w.z = cvt_pk_bf16(v1[0], v1[1]); w.w = cvt_pk_bf16(v1[2], v1[3]);
                        *(u32x4*)(rowp + bj * 128) = w; } }
            return;
        }
        const bool isg = (pn >= 20 && pn < 28);
        const float c1 = NL2E * (isg ? 1.5957691216057308f : 1.0f), c3 = NL2E * (isg ? 0.07135481627260025f : 0.0f);
#pragma unroll
        for (int ai = 0; ai < 2; ++ai)
#pragma unroll
            for (int m = 0; m < 4; ++m) { bf16_t* rowp = P + (size_t)(row0 + ai * 128 + m * 16) * LDP + col0;
#pragma unroll
                for (int bj = 0; bj < 2; ++bj) { const f32x4 x0 = acc[ai][bj][m][0] + p.bv[bj][0], x1 = acc[ai][bj][m][1] + p.bv[bj][1]; u32x4 w;
                    f32x4 t0 = (x0 * x0 * c3 + c1) * x0, t1 = (x1 * x1 * c3 + c1) * x1;
#pragma unroll
                    for (int j = 0; j < 4; ++j) { t0[j] = __builtin_amdgcn_exp2f(t0[j]); t1[j] = __builtin_amdgcn_exp2f(t1[j]); }
                    t0 = t0 + 1.0f; t1 = t1 + 1.0f;
#pragma unroll
                    for (int j = 0; j < 4; ++j) { t0[j] = __builtin_amdgcn_rcpf(t0[j]); t1[j] = __builtin_amdgcn_rcpf(t1[j]); }
                    t0 = t0 * x0; t1 = t1 * x1;
                    w.x = cvt_pk_bf16(t0[0], t0[1]); w.y = cvt_pk_bf16(t0[2], t0[3]); w.z = cvt_pk_bf16(t1[0], t1[1]); w.w = cvt_pk_bf16(t1[2], t1[3]);
                    *(u32x4*)(rowp + bj * 128) = w; } }
    }
};
struct EpiMerge {
    static constexpr bool PERM = true, AFTER_DRAIN = false, KHOOK = KHOOK_ON; static constexpr int H1 = 32, H2 = 48;
    const bf16_t* P; bf16_t* O;
    struct Pre {};
    __device__ __forceinline__ void pre_init(Pre&) const {}
    __device__ __forceinline__ void prefetch(Pre&, const Unit&, int, int, int, int) const {}
    __device__ __forceinline__ void khook(f32x4 (&acc)[2][2][4][2], const Unit& u, int t, int wr, int wc, int fr, int fq) const {
        const int row0 = u.pm * 256 + wr * 64 + fr, col0 = u.pn * 256 + wc * 32 + 8 * fq;
        const char* nbase = (const char*)(P + PG + (t == 32 ? 0 : D)); const char* dbase = nbase + D * 2;
        unsigned off0 = ((unsigned)row0 * LDP + col0) * 2u; asm volatile("" : "+v"(off0));
#pragma unroll
        for (int ai = 0; ai < 2; ++ai) {
            u32x4 nv[4][2], dv[4][2];
#pragma unroll
            for (int m = 0; m < 4; ++m)
#pragma unroll
                for (int bj = 0; bj < 2; ++bj) { const unsigned off = off0 + (unsigned)((ai * 128 + m * 16) * LDP * 2 + bj * 256); nv[m][bj] = *(const u32x4*)(nbase + off); dv[m][bj] = *(const u32x4*)(dbase + off); }
#pragma unroll
            for (int m = 0; m < 4; ++m)
#pragma unroll
                for (int bj = 0; bj < 2; ++bj) {
                    const u32x4 a = nv[m][bj], b = dv[m][bj];
                    acc[ai][bj][m][0][0] *= bf_lo(a.x) * __builtin_amdgcn_rcpf(bf_lo(b.x)); acc[ai][bj][m][0][1] *= bf_hi(a.x) * __builtin_amdgcn_rcpf(bf_hi(b.x));
                    acc[ai][bj][m][0][2] *= bf_lo(a.y) * __builtin_amdgcn_rcpf(bf_lo(b.y)); acc[ai][bj][m][0][3] *= bf_hi(a.y) * __builtin_amdgcn_rcpf(bf_hi(b.y));
                    acc[ai][bj][m][1][0] *= bf_lo(a.z) * __builtin_amdgcn_rcpf(bf_lo(b.z)); acc[ai][bj][m][1][1] *= bf_hi(a.z) * __builtin_amdgcn_rcpf(bf_hi(b.z));
                    acc[ai][bj][m][1][2] *= bf_lo(a.w) * __builtin_amdgcn_rcpf(bf_lo(b.w)); acc[ai][bj][m][1][3] *= bf_hi(a.w) * __builtin_amdgcn_rcpf(bf_hi(b.w));
                }
            asm volatile("" ::: "memory");
        }
    }
    __device__ __forceinline__ void operator()(const f32x4 (&acc)[2][2][4][2], const Unit& u, int wr, int wc, int fr, int fq, const Pre&) const {
        const int row0 = u.pm * 256 + wr * 64 + fr, col0 = u.pn * 256 + wc * 32 + 8 * fq;
        const bf16_t* g3 = P + PG + 2 * D + col0;
#pragma unroll
        for (int ai = 0; ai < 2; ++ai)
#pragma unroll
            for (int m = 0; m < 4; ++m) { const size_t row = (size_t)(row0 + ai * 128 + m * 16);
#pragma unroll
                for (int bj = 0; bj < 2; ++bj) { const u32x4 g = *(const u32x4*)(g3 + row * LDP + bj * 128); const f32x4 v0 = acc[ai][bj][m][0], v1 = acc[ai][bj][m][1]; u32x4 w;
                    w.x = cvt_pk_bf16(v0[0] * bf_lo(g.x), v0[1] * bf_hi(g.x)); w.y = cvt_pk_bf16(v0[2] * bf_lo(g.y), v0[3] * bf_hi(g.y));
                    w.z = cvt_pk_bf16(v1[0] * bf_lo(g.z), v1[1] * bf_hi(g.z)); w.w = cvt_pk_bf16(v1[2] * bf_lo(g.w), v1[3] * bf_hi(g.w));
                    *(u32x4*)(O + row * D + col0 + bj * 128) = w; } }
    }
};

__device__ __forceinline__ int map_row(int mode, int n) {
    if (mode == 1) return ((n >> 7) << 8) + (n & 127);
    if (mode == 2) return ((n >> 7) << 8) + 128 + (n & 127);
    if (mode == 3) return n < 5120 ? n : (n < 5184 ? PDT + (n - 5120) : n - 64);
    return n;
}
__device__ __forceinline__ void transpose_item(const float* W, int N, bf16_t* WT, int Kdst, int koff, int mode, LAS float* scr, int item, int lane) {
    LAS bf16_t* T = (LAS bf16_t*)scr;
    const int nblk = N / 64, kb = item / nblk, nb_ = item - kb * nblk, k0 = 64 * kb, n0 = 64 * nb_;
    const int lk = lane >> 4, n4 = (lane & 15) * 4;
    f32x4 v[16];
#pragma unroll
    for (int i = 0; i < 16; ++i) v[i] = __builtin_nontemporal_load((const f32x4*)(W + (size_t)(k0 + 4 * i + lk) * N + n0 + n4));
#pragma unroll
    for (int i = 0; i < 16; ++i) { u32x2 w; w.x = cvt_pk_bf16(v[i][0], v[i][1]); w.y = cvt_pk_bf16(v[i][2], v[i][3]); *(LAS u32x2*)(T + (4 * i + lk) * 72 + n4) = w; }
    LDS_WAIT();
    const int r0 = map_row(mode, n0);
    const int g = lane >> 4, i16 = lane & 15, q = i16 >> 2, p = i16 & 3;
#pragma unroll
    for (int nb = 0; nb < 4; ++nb)
#pragma unroll
        for (int kh = 0; kh < 2; ++kh) { const int kc = 4 * kh + g;
            const v4s t0 = __builtin_amdgcn_ds_read_tr16_b64_v4i16((LAS v4s*)(T + (8 * kc + q) * 72 + 16 * nb + 4 * p));
            const v4s t1 = __builtin_amdgcn_ds_read_tr16_b64_v4i16((LAS v4s*)(T + (8 * kc + 4 + q) * 72 + 16 * nb + 4 * p));
            const v8s o = __builtin_shufflevector(t0, t1, 0, 1, 2, 3, 4, 5, 6, 7);
            *(v8s*)(WT + (size_t)(r0 + 16 * nb + i16) * Kdst + koff + k0 + 8 * kc) = o; }
    LDS_WAIT();
}
constexpr int I_SQ = 64 * 64, I_IN = 64 * 321, I_BS = 32 * 64, I_BM = 16 * 64, IL_ITEMS = 7 * I_SQ + I_IN + I_BS + 2 * I_BM;
constexpr int CV_PRO = (int)(0.43 * IL_ITEMS), CV_INP = (int)(0.60 * IL_ITEMS), CV_MRG = (int)(0.83 * IL_ITEMS);
__device__ __forceinline__ void convert_items(Frame& F, int l, int i0, int i1, int w, int nw) {
    LAS float* scr = (LAS float*)(F.lds + F.wave * 16384);
    bf16_t* wl = WSP(bf16_t, WS_W + (size_t)l * LW_SIZE);
    const size_t sq = (size_t)l * D * D;
    for (int it = i0 + w; it < i1; it += nw) {
        int r = it;
        if (r < I_SQ) { transpose_item(F.in[8] + sq, D, wl + LW_13A / 2, D, 0, 1, scr, r, F.lane); continue; } r -= I_SQ;
        if (r < I_SQ) { transpose_item(F.in[9] + sq, D, wl + LW_13A / 2, D, 0, 2, scr, r, F.lane); continue; } r -= I_SQ;
        if (r < I_SQ) { transpose_item(F.in[10] + sq, D, wl + LW_2A / 2, D, 0, 0, scr, r, F.lane); continue; } r -= I_SQ;
        if (r < I_IN) { transpose_item(F.in[12] + (size_t)l * D * 20544, 20544, wl + LW_IN / 2, D, 0, 3, scr, r, F.lane); continue; } r -= I_IN;
        if (r < I_BS) { transpose_item(F.in[23] + (size_t)l * 2048 * D, D, wl + LW_BR / 2, D, 0, 0, scr, r, F.lane); continue; } r -= I_BS;
        if (r < I_BM) { transpose_item(F.in[24] + (size_t)l * 1024 * D, D, wl + LW_BR / 2, D, 2048, 0, scr, r, F.lane); continue; } r -= I_BM;
        if (r < I_BM) { transpose_item(F.in[25] + (size_t)l * 1024 * D, D, wl + LW_BR / 2, D, 3072, 0, scr, r, F.lane); continue; } r -= I_BM;
        if (r < I_SQ) { transpose_item(F.in[26] + sq, D, wl + LW_OUT / 2, D, 0, 0, scr, r, F.lane); continue; } r -= I_SQ;
        if (r < I_SQ) { transpose_item(F.in[28] + sq, D, wl + LW_13B / 2, D, 0, 1, scr, r, F.lane); continue; } r -= I_SQ;
        if (r < I_SQ) { transpose_item(F.in[29] + sq, D, wl + LW_13B / 2, D, 0, 2, scr, r, F.lane); continue; } r -= I_SQ;
        transpose_item(F.in[30] + sq, D, wl + LW_2B / 2, D, 0, 0, scr, r, F.lane);
    }
}
__device__ __forceinline__ void convert_in_tail(Frame& F, int l, int i0, int i1, int rem) {
    if (l >= NL || (int)blockIdx.x < rem) return;
    convert_items(F, l, i0, i1, ((int)blockIdx.x - rem) * NWAVES + F.wave, (F.G - rem) * NWAVES);
}
__device__ __forceinline__ void prologue_a(Frame& F) {
    for (int it = F.gw; it < IL_ITEMS + (NL - 1) * CV_PRO; it += F.NGW) {
        if (it < IL_ITEMS) convert_items(F, 0, it, it + 1, 0, 1);
        else { const int r = it - IL_ITEMS, l = 1 + r / CV_PRO, i = r % CV_PRO; convert_items(F, l, i, i + 1, 0, 1); }
    }
    const int gt = blockIdx.x * NTHR + F.tid, GT = F.G * NTHR;
    for (int i = gt; i < NL * 192 * (D / 8); i += GT) { const int l = i / (192 * (D / 8)), r = i - l * (192 * (D / 8));
        *(u32x4*)(WSP(bf16_t, WS_W + (size_t)l * LW_SIZE + LW_IN) + (size_t)20544 * D + (size_t)r * 8) = (u32x4){0u, 0u, 0u, 0u}; }
    for (int i = gt; i < NL * LDP; i += GT) { const int l = i / LDP, c = i - l * LDP; float v = 0.f;
        if (c < 5120) v = F.in[13][(size_t)l * 20544 + c];
        else if (c < PDT) v = F.in[13][(size_t)l * 20544 + c + 64];
        else if (c < PDT + 64) v = F.in[13][(size_t)l * 20544 + 5120 + (c - PDT)] + F.in[17][l * 64 + (c - PDT)];
        WSP(float, WS_BIN)[i] = v; }
    for (int i = gt; i < NL * 8 * 128 * 128; i += GT) WSP(bf16_t, WS_SGW)[i] = f2bf(F.in[21][i]);
    for (int i = gt; i < 128 * 128; i += GT) { const int k = i >> 7, n = i & 127; const float a = (float)((k * n) & 127) * (1.0f / 64.0f);
        const float c = cospif(a), s = sinpif(a);
        WSP(bf16_t, WS_TAB + TAB_CW)[i] = f2h(c); WSP(bf16_t, WS_TAB + TAB_SW)[i] = f2h(s); WSP(bf16_t, WS_TAB + TAB_SWN)[i] = f2h(-s);
        const float b = (float)((k * n) & 16383) * (1.0f / 8192.0f);
        WSP(float, WS_TAB + TAB_TW)[2 * i] = cospif(b); WSP(float, WS_TAB + TAB_TW)[2 * i + 1] = sinpif(b); }
    for (int i = gt; i < 128; i += GT) { const float b = (float)i * (1.0f / 128.0f); WSP(float, WS_TAB + TAB_TWC)[2 * i] = cospif(b); WSP(float, WS_TAB + TAB_TWC)[2 * i + 1] = sinpif(b); }
    for (int b = blockIdx.x; b < 2 * NL * 32; b += F.G) {
        const int l = b >> 6, v = (b >> 5) & 1, r = (b & 31) * 8 + F.wave; const float* cv = v ? F.in[3] : F.in[1];
        const float* w1 = F.in[4] + (size_t)l * D * 256 + r; float s_ = 0.f;
#pragma unroll 8
        for (int d = F.lane; d < D; d += 64) s_ += silu_f(cv[d]) * w1[(size_t)d * 256];
        s_ = wave_sum(s_);
        if (F.lane == 0) WSP(float, WS_T1)[(l * 2 + v) * 256 + r] = s_;
    }
}
__device__ __forceinline__ void prologue_b(Frame& F) {
    const int gt = blockIdx.x * NTHR + F.tid, GT = F.G * NTHR;
    for (int i = gt; i < NL * 9 * D; i += GT) { const int l = i / (9 * D), n = i - l * (9 * D);
        const float* w2 = F.in[5] + (size_t)l * 256 * 9 * D + n; const float* t0 = WSP(float, WS_T1) + (l * 2) * 256; const float* t1 = t0 + 256;
        float s0 = 0.f, s1 = 0.f;
#pragma unroll 8
        for (int r = 0; r < 256; ++r) { const float w = w2[(size_t)r * 9 * D]; s0 += t0[r] * w; s1 += t1[r] * w; }
        const float b = F.in[6][(size_t)l * 9 * D + n];
        WSP(float, WS_MOD)[(size_t)(l * 2 + 0) * 9 * D + n] = s0 + b; WSP(float, WS_MOD)[(size_t)(l * 2 + 1) * 9 * D + n] = s1 + b; }
}
__device__ __forceinline__ const float* modv(Frame& F, int l, int v, int j) { return WSP(float, WS_MOD) + ((size_t)(l * 2 + v) * 9 + j) * D; }

struct NormRow { f32x4 x[16]; u32x2 d[16]; };
__device__ __forceinline__ void norm_load(NormRow& R, const float* src, const bf16_t* dl, int lane) {
#pragma unroll
    for (int j = 0; j < 16; ++j) R.x[j] = *(const f32x4*)(src + lane * 4 + 256 * j);
    if (dl) {
#pragma unroll
        for (int j = 0; j < 16; ++j) R.d[j] = *(const u32x2*)(dl + lane * 4 + 256 * j); }
}
__device__ __forceinline__ void norm_rows(Frame& F, const float* xin, const float* cin, float* xout, float* cout, const bf16_t* DL, int row0, int rstride, int rend, const bf16_t* DL2 = nullptr) {
    LAS float* GM = (LAS float*)F.lds; LAS float* SH = GM + 2 * D;
    bf16_t* H = WSP(bf16_t, WS_H);
    NormRow R, Rn;
    int row = row0;
    if (row < rend) { const int v = row >= NX; const size_t ro = v ? (size_t)(row - NX) * D : (size_t)row * D; norm_load(R, (v ? cin : xin) + ro, DL ? DL + (size_t)row * D : DL, F.lane); }
    for (; row < rend; row += rstride) {
        const int rn = row + rstride;
        if (rn < rend) { const int vn = rn >= NX; const size_t rno = vn ? (size_t)(rn - NX) * D : (size_t)rn * D; norm_load(Rn, (vn ? cin : xin) + rno, DL ? DL + (size_t)rn * D : DL, F.lane); }
        const int v = row >= NX; const size_t ro = v ? (size_t)(row - NX) * D : (size_t)row * D;
        float ss = 0.f;
        if (DL) { float* dst = (v ? cout : xout) + ro;
            if (DL2) {
#pragma unroll
                for (int j = 0; j < 16; ++j) { const u32x2 d = *(const u32x2*)(DL2 + (size_t)row * D + F.lane * 4 + 256 * j); R.x[j] = R.x[j] + (f32x4){bf_lo(d.x), bf_hi(d.x), bf_lo(d.y), bf_hi(d.y)}; } }
#pragma unroll
            for (int j = 0; j < 16; ++j) { const u32x2 d = R.d[j];
                R.x[j] = R.x[j] + (f32x4){bf_lo(d.x), bf_hi(d.x), bf_lo(d.y), bf_hi(d.y)}; *(f32x4*)(dst + F.lane * 4 + 256 * j) = R.x[j]; } }
#pragma unroll
        for (int j = 0; j < 16; ++j) ss += (R.x[j][0] * R.x[j][0] + R.x[j][1] * R.x[j][1]) + (R.x[j][2] * R.x[j][2] + R.x[j][3] * R.x[j][3]);
        const float rinv = 1.0f / sqrtf(wave_sum(ss) * (1.0f / D) + EPS);
#pragma unroll
        for (int j = 0; j < 16; ++j) { const int c = F.lane * 4 + 256 * j; const f32x4 gm = *(const LAS f32x4*)(GM + v * D + c), sh = *(const LAS f32x4*)(SH + v * D + c);
            const f32x4 o = R.x[j] * rinv * gm + sh; u32x2 w; w.x = cvt_pk_bf16(o[0], o[1]); w.y = cvt_pk_bf16(o[2], o[3]);
            *(u32x2*)(H + (size_t)row * D + c) = w; }
        if (rn < rend) {
#pragma unroll
            for (int j = 0; j < 16; ++j) { R.x[j] = Rn.x[j]; R.d[j] = Rn.d[j]; } }
    }
}
struct CtxOrder {
    int c;
    __device__ bool next(int i, pg8::Unit& u) const { if (i != 0) return false; u.pm = 64; u.pn = c; return true; }
    __device__ __forceinline__ void a_ready(const pg8::Unit&) const {}
    __device__ __forceinline__ void done(const pg8::Unit&) const {}
};
struct CtxWork { bool on; const bf16_t* A; const bf16_t* Bt; const float* coefc; float scale; unsigned* cnt; };
__device__ __forceinline__ void norm_phase(Frame& F, const float* xin, const float* cin, float* xout, float* cout, const bf16_t* DL, const float* g, int l, int jsh, int nrows, const CtxWork cw) {
    const bool team = cw.on && blockIdx.x < 32;
    if (team) {
        const int kh = (int)blockIdx.x >> 4;
        pg8::Gemm gg{cw.A + kh * 2048, cw.Bt + kh * 2048, NT, D, 2048, D}; CtxOrder S{(int)blockIdx.x & 15}; EpiDelta E{kh ? WSP(bf16_t, WS_DL2) : WSP(bf16_t, WS_DL), cw.coefc, cw.coefc, cw.scale};
        pg8::gemm_phase<EpiDelta, CtxOrder, true, true>(F.lds, gg, S, E);
        __builtin_amdgcn_fence(__ATOMIC_RELEASE, "agent"); asm volatile("s_waitcnt vmcnt(0)" ::: "memory");
        __syncthreads();
        if (F.tid == 0) (void)__hip_atomic_fetch_add(cw.cnt, 1u, __ATOMIC_RELAXED, __HIP_MEMORY_SCOPE_AGENT);
    }
    LAS float* GM = (LAS float*)F.lds;
    LAS float* SH = GM + 2 * D;
    __syncthreads();
    for (int i = F.tid; i < 2 * D; i += NTHR) { const int v = i >> 12, c = i & (D - 1); GM[i] = g[c] * (1.0f + modv(F, l, v, jsh + 1)[c]); SH[i] = modv(F, l, v, jsh)[c]; }
    __syncthreads();
    if (!cw.on) norm_rows(F, xin, cin, xout, cout, DL, F.gw, F.NGW, nrows);
    else if (!team) norm_rows(F, xin, cin, xout, cout, DL, ((int)blockIdx.x - 32) * NWAVES + F.wave, (F.G - 32) * NWAVES, NX);
    else {
        if (F.tid == 0) { unsigned sp = 0; while (__hip_atomic_load(cw.cnt, __ATOMIC_RELAXED, __HIP_MEMORY_SCOPE_AGENT) < 32u) { __builtin_amdgcn_s_sleep(2); if (++sp > (1u << 22)) break; }
            __builtin_amdgcn_fence(__ATOMIC_ACQUIRE, "agent"); asm volatile("s_waitcnt vmcnt(0)" ::: "memory"); }
        __syncthreads();
        norm_rows(F, xin, cin, xout, cout, DL, NX + (int)blockIdx.x * NWAVES + F.wave, 32 * NWAVES, NT, WSP(bf16_t, WS_DL2));
    }
    __syncthreads();
}
__device__ __forceinline__ void final_norm_phase(Frame& F, const bf16_t* DL, const float* g) {
    for (int row = F.gw; row < NX; row += F.NGW) {
        float* src = F.out + (size_t)row * D;
        f32x4 x[16]; float ss = 0.f;
#pragma unroll
        for (int j = 0; j < 16; ++j) { const u32x2 d = *(const u32x2*)(DL + (size_t)row * D + F.lane * 4 + 256 * j);
            x[j] = *(const f32x4*)(src + F.lane * 4 + 256 * j) + (f32x4){bf_lo(d.x), bf_hi(d.x), bf_lo(d.y), bf_hi(d.y)};
            ss += (x[j][0] * x[j][0] + x[j][1] * x[j][1]) + (x[j][2] * x[j][2] + x[j][3] * x[j][3]); }
        const float rinv = 1.0f / sqrtf(wave_sum(ss) * (1.0f / D) + EPS);
#pragma unroll
        for (int j = 0; j < 16; ++j) { const int c = F.lane * 4 + 256 * j; *(f32x4*)(src + c) = x[j] * rinv * *(const f32x4*)(g + c); }
    }
}

struct ConvRegs { u32x4 v[5][2]; };
__device__ __forceinline__ void conv_load(Frame& F, ConvRegs& R, int ci, int cb) {
    const bf16_t* P = WSP(bf16_t, WS_P);
    const int t0 = chunk_t0(ci), q = F.tid >> 2, cq = F.tid & 3, ch0 = cb * 64 + cq * 16, tq = t0 + q;
    const int seg_lo = ci < 2 ? NX : (tq & ~63), seg_hi = ci < 2 ? NT : seg_lo + 64;
#pragma unroll
    for (int k = 0; k < 5; ++k) { const int ts = tq + k - 2; const bool ok = ts >= seg_lo && ts < seg_hi; const int tc = ok ? ts : tq;
        const u32x4 a = *(const u32x4*)(P + (size_t)tc * LDP + PXBC + ch0), b = *(const u32x4*)(P + (size_t)tc * LDP + PXBC + ch0 + 8);
        R.v[k][0] = ok ? a : (u32x4){0u, 0u, 0u, 0u}; R.v[k][1] = ok ? b : (u32x4){0u, 0u, 0u, 0u}; }
}
__device__ __forceinline__ void conv_compute(Frame& F, const ConvRegs& R, int l, int ci, int cb) {
    bf16_t* XC = WSP(bf16_t, WS_XC); bf16_t* XT = WSP(bf16_t, WS_XT);
    LAS bf16_t* T = (LAS bf16_t*)F.lds; constexpr int TS = 136;
    const int t0 = chunk_t0(ci), q = F.tid >> 2, cq = F.tid & 3, ch0 = cb * 64 + cq * 16, tq = t0 + q;
    const LAS float* cw = (const LAS float*)(F.lds + 32768) + ch0; const LAS float* cbv = cw + 5 * 3072;
    float a[16];
#pragma unroll
    for (int j = 0; j < 4; ++j) { const f32x4 b = *(const LAS f32x4*)(cbv + 4 * j); a[4 * j] = b[0]; a[4 * j + 1] = b[1]; a[4 * j + 2] = b[2]; a[4 * j + 3] = b[3]; }
#pragma unroll
    for (int k = 0; k < 5; ++k) { const u32x4 v0 = R.v[k][0], v1 = R.v[k][1];
        const float x[16] = {bf_lo(v0.x), bf_hi(v0.x), bf_lo(v0.y), bf_hi(v0.y), bf_lo(v0.z), bf_hi(v0.z), bf_lo(v0.w), bf_hi(v0.w), bf_lo(v1.x), bf_hi(v1.x), bf_lo(v1.y), bf_hi(v1.y), bf_lo(v1.z), bf_hi(v1.z), bf_lo(v1.w), bf_hi(v1.w)};
#pragma unroll
        for (int j = 0; j < 4; ++j) { const f32x4 w = *(const LAS f32x4*)(cw + k * 3072 + 4 * j); a[4 * j] += w[0] * x[4 * j]; a[4 * j + 1] += w[1] * x[4 * j + 1]; a[4 * j + 2] += w[2] * x[4 * j + 2]; a[4 * j + 3] += w[3] * x[4 * j + 3]; } }
#pragma unroll
    for (int j = 0; j < 16; ++j) a[j] = silu_f(a[j]);
    u32x4 o0, o1; o0.x = cvt_pk_bf16(a[0], a[1]); o0.y = cvt_pk_bf16(a[2], a[3]); o0.z = cvt_pk_bf16(a[4], a[5]); o0.w = cvt_pk_bf16(a[6], a[7]);
    o1.x = cvt_pk_bf16(a[8], a[9]); o1.y = cvt_pk_bf16(a[10], a[11]); o1.z = cvt_pk_bf16(a[12], a[13]); o1.w = cvt_pk_bf16(a[14], a[15]);
    *(u32x4*)(XC + (size_t)tq * 3072 + ch0) = o0; *(u32x4*)(XC + (size_t)tq * 3072 + ch0 + 8) = o1;
    if (cb < 40) {
        const unsigned w[8] = {o0.x, o0.y, o0.z, o0.w, o1.x, o1.y, o1.z, o1.w};
#pragma unroll
        for (int j = 0; j < 8; ++j) { T[(cq * 16 + 2 * j) * TS + q] = (bf16_t)(w[j] & 0xffffu); T[(cq * 16 + 2 * j + 1) * TS + q] = (bf16_t)(w[j] >> 16); }
        LDS_BAR();
        const int r = F.tid >> 3, part = F.tid & 7;
        const u32x4 t0v = *(const LAS u32x4*)(T + r * TS + part * 16), t1v = *(const LAS u32x4*)(T + r * TS + part * 16 + 8);
        bf16_t* dst = XT + (size_t)(cb * 64 + r) * NT + t0 + part * 16;
        *(u32x4*)dst = t0v; *(u32x4*)(dst + 8) = t1v;
        LDS_BAR();
    }
}
__device__ __forceinline__ void conv_all(Frame& F, int l) {
    constexpr int NU = NCHK * 48;
    { LAS float* wl_ = (LAS float*)(F.lds + 32768);
      __syncthreads();
      for (int i = F.tid; i < 5 * 3072 / 4; i += NTHR) *(LAS f32x4*)(wl_ + 4 * i) = *(const f32x4*)(F.in[14] + (size_t)l * 5 * 3072 + 4 * i);
      for (int i = F.tid; i < 3072 / 4; i += NTHR) *(LAS f32x4*)(wl_ + 5 * 3072 + 4 * i) = *(const f32x4*)(F.in[15] + (size_t)l * 3072 + 4 * i);
      __syncthreads(); }
    ConvRegs R0, R1;
    int u = blockIdx.x;
    if (u < NU) conv_load(F, R0, u / 48, u % 48);
    for (; u < NU; u += 2 * F.G) {
        const int u1 = u + F.G, u2 = u + 2 * F.G;
        { const int v1 = u1 < NU ? u1 : u; conv_load(F, R1, v1 / 48, v1 % 48); }
        conv_compute(F, R0, l, u / 48, u % 48);
        { const int v2 = u2 < NU ? u2 : u; conv_load(F, R0, v2 / 48, v2 % 48); }
        if (u1 < NU) conv_compute(F, R1, l, u1 / 48, u1 % 48);
    }
}
__device__ __forceinline__ void cumsum_job(Frame& F, int l, int job) {
    const int ci = job >> 3, d = (job >> 2) & 1, hg = job & 3, t0 = chunk_t0(ci), lane = F.lane, hd = hg * 8 + (lane & 7), sg = lane >> 3;
    const float* DT = WSP(float, WS_DT) + (size_t)(t0 + 16 * sg) * 64 + d * 32 + hd;
    const float Aneg = -expf(F.in[16][l * 64 + d * 32 + hd]);
    float dtv[16]; float part = 0.f;
#pragma unroll
    for (int k = 0; k < 16; ++k) { dtv[k] = DT[(size_t)k * 64]; part += dtv[k] * Aneg; }
    float incl = part;
#pragma unroll
    for (int o = 8; o < 64; o <<= 1) { const float t = __shfl_up(incl, o); if (lane >= o) incl += t; }
    const float total = __shfl(incl, 56 + (lane & 7));
    float run = incl - part;
    const size_t o0 = ((size_t)d * NT + t0 + 16 * sg) * 32 + hd;
    float* CSp = WSP(float, WS_CS) + o0; float* EIp = WSP(float, WS_EIN) + o0; float* WEp = WSP(float, WS_WEND) + o0;
#pragma unroll
    for (int k = 0; k < 16; ++k) { const float dt = dtv[k], a = dt * Aneg;
        const float c = d == 0 ? run + a : total - run;
        run += a;
        CSp[(size_t)k * 32] = c; EIp[(size_t)k * 32] = __expf(c); WEp[(size_t)k * 32] = __expf(total - c) * dt; }
    if (sg == 0) WSP(float, WS_TOT)[(d * NCHK + ci) * 32 + hd] = total;
}
__device__ __forceinline__ void vrms_job4(Frame& F, int tb) {
    u32x4 a[4], b[4]; float ss[4];
#pragma unroll
    for (int r = 0; r < 4; ++r) { const int t = tb + r < NT ? tb + r : NT - 1; const bf16_t* p = WSP(bf16_t, WS_P) + (size_t)t * LDP + PV + F.lane * 16; a[r] = *(const u32x4*)p; b[r] = *(const u32x4*)(p + 8); }
#pragma unroll
    for (int r = 0; r < 4; ++r) { const unsigned w[8] = {a[r].x, a[r].y, a[r].z, a[r].w, b[r].x, b[r].y, b[r].z, b[r].w}; float s_ = 0.f;
#pragma unroll
        for (int j = 0; j < 8; ++j) { const float lo = bf_lo(w[j]), hi = bf_hi(w[j]); s_ += lo * lo + hi * hi; }
        ss[r] = s_; }
#pragma unroll
    for (int o = 1; o < 64; o <<= 1) {
#pragma unroll
        for (int r = 0; r < 4; ++r) ss[r] += __shfl_xor(ss[r], o); }
    if (F.lane < 4 && tb + F.lane < NT) { const float v = F.lane == 0 ? ss[0] : F.lane == 1 ? ss[1] : F.lane == 2 ? ss[2] : ss[3]; WSP(float, WS_RINV)[tb + F.lane] = 1.0f / sqrtf(v * (1.0f / 1024.0f) + EPS); }
}
__device__ __forceinline__ void fft_tables_to_lds(Frame& F, const bf16_t* t0, const bf16_t* t1) {
    LAS bf16_t* L0 = (LAS bf16_t*)(F.lds + 65536); LAS bf16_t* L1 = L0 + 128 * 136;
    __syncthreads();
    for (int i = F.tid; i < 2048; i += NTHR) { const int r = i >> 4, c = (i & 15) * 8; *(LAS u32x4*)(L0 + r * 136 + c) = *(const u32x4*)(t0 + r * 128 + c); *(LAS u32x4*)(L1 + r * 136 + c) = *(const u32x4*)(t1 + r * 128 + c); }
    __syncthreads();
}
__device__ __forceinline__ void fft1_unit(Frame& F, int lb2, int g, int mb) {
    const bf16_t* P = WSP(bf16_t, WS_P);
    bf16_t* GR = WSP(bf16_t, WS_GPR); bf16_t* GI = WSP(bf16_t, WS_GPI);
    LAS bf16_t* LR = (LAS bf16_t*)F.lds;
    LAS bf16_t* LI = LR + 128 * 16 * 8;
    const LAS bf16_t* CWl = (const LAS bf16_t*)(F.lds + 65536); const LAS bf16_t* SWl = CWl + 128 * 136;
    const int w = F.wave, l15 = F.lane & 15, h = F.lane >> 4, l2 = 8 * lb2 + w;
    f32x4 zr[8], zi[8];
    v8s bc[4], bs[4];
    v8s af[8][4];
    const bf16_t* rowb = P + (size_t)(128 * l15 + l2) * LDP + PF + g * 128 + 8 * h;
#pragma unroll
    for (int lb = 0; lb < 4; ++lb)
#pragma unroll
        for (int ks = 0; ks < 4; ++ks) af[lb][ks] = ld16(rowb + (size_t)(2048 * lb) * LDP + 32 * ks);
#pragma unroll
    for (int ks = 0; ks < 4; ++ks) { bc[ks] = *(const LAS v8s*)(CWl + (16 * mb + l15) * 136 + 32 * ks + 8 * h); bs[ks] = *(const LAS v8s*)(SWl + (16 * mb + l15) * 136 + 32 * ks + 8 * h); }
    asm volatile("" ::: "memory");
#pragma unroll
    for (int lb = 4; lb < 8; ++lb)
#pragma unroll
        for (int ks = 0; ks < 4; ++ks) af[lb][ks] = ld16(rowb + (size_t)(2048 * lb) * LDP + 32 * ks);
    asm volatile("" ::: "memory");
#pragma unroll
    for (int lb = 0; lb < 8; ++lb) { zr[lb] = (f32x4){0.f, 0.f, 0.f, 0.f}; zi[lb] = zr[lb];
#pragma unroll
        for (int ks = 0; ks < 4; ++ks) { zr[lb] = mma_h(af[lb][ks], bc[ks], zr[lb]); zi[lb] = mma_h(af[lb][ks], bs[ks], zi[lb]); } }
    v8s br[4], bi[4], bn[4];
#pragma unroll
    for (int ks = 0; ks < 4; ++ks) { const f32x4 a = zr[2 * ks], b = zr[2 * ks + 1], c = zi[2 * ks], d = zi[2 * ks + 1];
        br[ks] = pack8_h(a[0], a[1], a[2], a[3], b[0], b[1], b[2], b[3]); bi[ks] = pack8_h(c[0], c[1], c[2], c[3], d[0], d[1], d[2], d[3]);
        bn[ks] = pack8_h(-c[0], -c[1], -c[2], -c[3], -d[0], -d[1], -d[2], -d[3]); }
    __syncthreads();
#pragma unroll 2
    for (int kb = 0; kb < 8; ++kb) {
        f32x4 gr = {0.f, 0.f, 0.f, 0.f}, gi = gr;
        const LAS bf16_t* cr = CWl + (16 * kb + l15) * 136 + 4 * h; const LAS bf16_t* sr = SWl + (16 * kb + l15) * 136 + 4 * h;
#pragma unroll
        for (int ks = 0; ks < 4; ++ks) {
            const v4s c0 = *(const LAS v4s*)(cr + 32 * ks), c1 = *(const LAS v4s*)(cr + 32 * ks + 16), s0 = *(const LAS v4s*)(sr + 32 * ks), s1 = *(const LAS v4s*)(sr + 32 * ks + 16);
            const v8s ac = __builtin_shufflevector(c0, c1, 0, 1, 2, 3, 4, 5, 6, 7), as = __builtin_shufflevector(s0, s1, 0, 1, 2, 3, 4, 5, 6, 7);
            gr = mma_h(ac, br[ks], gr); gr = mma_h(as, bn[ks], gr); gi = mma_h(ac, bi[ks], gi); gi = mma_h(as, br[ks], gi); }
#pragma unroll
        for (int r = 0; r < 4; ++r) { const int k1 = 16 * kb + 4 * h + r; const float ang = (float)((k1 * l2) & 16383) * (1.0f / 16384.0f);
            const float ct = __builtin_amdgcn_cosf(ang), st = __builtin_amdgcn_sinf(ang);
            const float pr = gr[r] * ct - gi[r] * st, pi = gr[r] * st + gi[r] * ct;
            LR[(k1 * 16 + l15) * 8 + w] = f2h(pr); LI[(k1 * 16 + l15) * 8 + w] = f2h(pi); }
    }
    __syncthreads();
#pragma unroll
    for (int j = 0; j < 4; ++j) { const int p = F.tid + NTHR * j, k1 = p >> 4, c = p & 15;
        const size_t o = ((size_t)k1 * 1024 + g * 128 + 16 * mb + c) * 128 + 8 * lb2;
        *(u32x4*)(GR + o) = *(const LAS u32x4*)(LR + p * 8); *(u32x4*)(GI + o) = *(const LAS u32x4*)(LI + p * 8); }
}
__device__ __forceinline__ void fft1c_unit(Frame& F, int g) {
    const bf16_t* P = WSP(bf16_t, WS_P); const bf16_t* CW = WSP(bf16_t, WS_TAB + TAB_CW); const bf16_t* SW = WSP(bf16_t, WS_TAB + TAB_SW);
    const float* TWC = WSP(float, WS_TAB + TAB_TWC);
    bf16_t* GR = WSP(bf16_t, WS_GPC); bf16_t* GI = WSP(bf16_t, WS_GPC + MiB);
    const int w = F.wave, l15 = F.lane & 15, h = F.lane >> 4;
    v8s bc[4], bs[4];
#pragma unroll
    for (int ks = 0; ks < 4; ++ks) { bc[ks] = ld16(CW + (16 * w + l15) * 128 + 32 * ks + 8 * h); bs[ks] = ld16(SW + (16 * w + l15) * 128 + 32 * ks + 8 * h); }
    const int ch = g * 128 + 16 * w + l15;
#pragma unroll 1
    for (int lb = 0; lb < 8; ++lb) {
        f32x4 ar = {0.f, 0.f, 0.f, 0.f}, ai = ar, br = ar, bi = ar;
        const bf16_t* ra = P + (size_t)(NX + 16 * lb + l15) * LDP + PF + g * 128 + 8 * h; const bf16_t* rb = ra + (size_t)128 * LDP;
#pragma unroll
        for (int ks = 0; ks < 4; ++ks) { const v8s a = ld16(ra + 32 * ks), b = ld16(rb + 32 * ks);
            ar = mma_h(a, bc[ks], ar); ai = mma_h(a, bs[ks], ai); br = mma_h(b, bc[ks], br); bi = mma_h(b, bs[ks], bi); }
        unsigned short o0r[4], o0i[4], o1r[4], o1i[4];
#pragma unroll
        for (int r = 0; r < 4; ++r) { const int l2 = 16 * lb + 4 * h + r; const f32x2 tw = *(const f32x2*)(TWC + 2 * l2);
            const float sr = ar[r] + br[r], si = ai[r] + bi[r], dr = ar[r] - br[r], di = ai[r] - bi[r];
            o0r[r] = f2h(sr); o0i[r] = f2h(si); o1r[r] = f2h(dr * tw.x - di * tw.y); o1i[r] = f2h(dr * tw.y + di * tw.x); }
        const size_t o0 = ((size_t)0 * 1024 + ch) * 128 + 16 * lb + 4 * h, o1 = ((size_t)1 * 1024 + ch) * 128 + 16 * lb + 4 * h;
        *(u32x2*)(GR + o0) = (u32x2){(unsigned)o0r[0] | ((unsigned)o0r[1] << 16), (unsigned)o0r[2] | ((unsigned)o0r[3] << 16)};
        *(u32x2*)(GI + o0) = (u32x2){(unsigned)o0i[0] | ((unsigned)o0i[1] << 16), (unsigned)o0i[2] | ((unsigned)o0i[3] << 16)};
        *(u32x2*)(GR + o1) = (u32x2){(unsigned)o1r[0] | ((unsigned)o1r[1] << 16), (unsigned)o1r[2] | ((unsigned)o1r[3] << 16)};
        *(u32x2*)(GI + o1) = (u32x2){(unsigned)o1i[0] | ((unsigned)o1i[1] << 16), (unsigned)o1i[2] | ((unsigned)o1i[3] << 16)};
    }
}
__device__ __forceinline__ void fft2_unit(Frame& F, const bf16_t* GR, const bf16_t* GI, int k1, int g, int rowbase, int KS, float scale) {
    const LAS bf16_t* CWl = (const LAS bf16_t*)(F.lds + 65536); const LAS bf16_t* SNl = CWl + 128 * 136;
    bf16_t* Y = WSP(bf16_t, WS_Y);
    const int w = F.wave, l15 = F.lane & 15, h = F.lane >> 4;
    v8s ar[4], ai[4];
    const size_t ab = ((size_t)k1 * 1024 + g * 128 + 16 * w + l15) * 128 + 8 * h;
#pragma unroll
    for (int ks = 0; ks < 4; ++ks) { ar[ks] = ld16(GR + ab + 32 * ks); ai[ks] = ld16(GI + ab + 32 * ks); }
#pragma unroll 2
    for (int kb = 0; kb < 8; ++kb) {
        f32x4 acc = {0.f, 0.f, 0.f, 0.f};
        const LAS bf16_t* cr = CWl + (16 * kb + l15) * 136 + 8 * h; const LAS bf16_t* sr = SNl + (16 * kb + l15) * 136 + 8 * h;
#pragma unroll
        for (int ks = 0; ks < 4; ++ks) { acc = mma_h(ar[ks], *(const LAS v8s*)(cr + 32 * ks), acc); acc = mma_h(ai[ks], *(const LAS v8s*)(sr + 32 * ks), acc); }
        const int row = rowbase + k1 + KS * (16 * kb + l15);
        u32x2 o; o.x = cvt_pk_bf16(acc[0] * scale, acc[1] * scale); o.y = cvt_pk_bf16(acc[2] * scale, acc[3] * scale);
        *(u32x2*)(Y + (size_t)row * D + 3072 + g * 128 + 16 * w + 4 * h) = o;
    }
}

struct LocPF { u32x4 x[2]; float w; };
__device__ __forceinline__ void loc_pf_x(Frame& F, LocPF& P, int t0, int hd) {
    const bf16_t* XT = WSP(bf16_t, WS_XT);
#pragma unroll
    for (int j = 0; j < 2; ++j) { const int id = F.tid + NTHR * j, row = id >> 4, c = (id & 15) * 8; P.x[j] = *(const u32x4*)(XT + (size_t)(hd * 64 + row) * NT + t0 + c); }
    { const int t = F.tid & 255, dd = t >> 7, s_ = t & 127; P.w = WSP(float, WS_WEND)[((size_t)dd * NT + t0 + s_) * 32 + hd]; }
}
__device__ __forceinline__ void loc_commit_x(Frame& F, const LocPF& P, LAS bf16_t* XAl, LAS float* wl) {
#pragma unroll
    for (int j = 0; j < 2; ++j) { const int id = F.tid + NTHR * j, row = id >> 4, c = (id & 15) * 8; *(LAS u32x4*)(XAl + row * 136 + c) = P.x[j]; }
    if (F.tid < 256) wl[F.tid] = P.w;
}
__device__ __forceinline__ void ssd_local_unit4(Frame& F, int ci, int hd0) {
    const bf16_t* XT = WSP(bf16_t, WS_XT); bf16_t* LS = WSP(bf16_t, WS_LS);
    LAS bf16_t* BTl = (LAS bf16_t*)F.lds;
    LAS bf16_t* XAl = BTl + 128 * 136;
    LAS float* wl = (LAS float*)(XAl + 64 * 136);
    const int t0 = chunk_t0(ci), g = hd0 >> 3, w = F.wave, l15 = F.lane & 15, h = F.lane >> 4, d = w >> 2, nq = w & 3;
    u32x4 pb_[4]; LocPF P;
#pragma unroll
    for (int j = 0; j < 4; ++j) { const int id = F.tid + NTHR * j, row = id >> 4, c = (id & 15) * 8; pb_[j] = *(const u32x4*)(XT + (size_t)(2048 + g * 128 + row) * NT + t0 + c); }
    loc_pf_x(F, P, t0, hd0);
    LDS_BAR();
#pragma unroll
    for (int j = 0; j < 4; ++j) { const int id = F.tid + NTHR * j, row = id >> 4, c = (id & 15) * 8; *(LAS u32x4*)(BTl + row * 136 + c) = pb_[j]; }
    loc_commit_x(F, P, XAl, wl);
    loc_pf_x(F, P, t0, hd0 + 1);
    LDS_BAR();
    v8s bfr[4][2];
#pragma unroll
    for (int ks = 0; ks < 4; ++ks)
#pragma unroll
        for (int nb = 0; nb < 2; ++nb) bfr[ks][nb] = *(const LAS v8s*)(BTl + (nq * 32 + 16 * nb + l15) * 136 + 32 * ks + 8 * h);
#pragma unroll
    for (int j = 0; j < 4; ++j) {
        const int hd = hd0 + j;
        if (j > 0) LDS_BAR();
        f32x4 acc[4][2];
#pragma unroll
        for (int pb = 0; pb < 4; ++pb) { acc[pb][0] = (f32x4){0.f, 0.f, 0.f, 0.f}; acc[pb][1] = acc[pb][0]; }
#pragma unroll
        for (int ks = 0; ks < 4; ++ks) {
            const f32x4 w0 = *(const LAS f32x4*)(wl + d * 128 + 32 * ks + 8 * h), w1 = *(const LAS f32x4*)(wl + d * 128 + 32 * ks + 8 * h + 4);
#pragma unroll
            for (int pb = 0; pb < 4; ++pb) {
                const u32x4 raw = *(const LAS u32x4*)(XAl + (16 * pb + l15) * 136 + 32 * ks + 8 * h);
                const v8s a = pack8_bf(bf_lo(raw.x) * w0[0], bf_hi(raw.x) * w0[1], bf_lo(raw.y) * w0[2], bf_hi(raw.y) * w0[3], bf_lo(raw.z) * w1[0], bf_hi(raw.z) * w1[1], bf_lo(raw.w) * w1[2], bf_hi(raw.w) * w1[3]);
                acc[pb][0] = mma_bf(bfr[ks][0], a, acc[pb][0]); acc[pb][1] = mma_bf(bfr[ks][1], a, acc[pb][1]);
            }
        }
        if (j < 3) { LDS_BAR(); loc_commit_x(F, P, XAl, wl); if (j < 2) loc_pf_x(F, P, t0, hd + 2); }
        bf16_t* dst = LS + ((size_t)(d * NCHK + ci) * 32 + hd) * 8192;
#pragma unroll
        for (int pb = 0; pb < 4; ++pb)
#pragma unroll
            for (int nb = 0; nb < 2; ++nb) { u32x2 o; o.x = cvt_pk_bf16(acc[pb][nb][0], acc[pb][nb][1]); o.y = cvt_pk_bf16(acc[pb][nb][2], acc[pb][nb][3]);
                *(u32x2*)(dst + (16 * pb + l15) * 128 + nq * 32 + 16 * nb + 4 * h) = o; }
        if (ci < 2) {
            bf16_t* sec = WSP(bf16_t, WS_SEC) + ((size_t)(d * 2 + (1 - ci)) * 32 + hd) * 8192; const bool keep = (d == ci);
#pragma unroll
            for (int pb = 0; pb < 4; ++pb)
#pragma unroll
                for (int nb = 0; nb < 2; ++nb)
                    { u32x2 o; o.x = keep ? cvt_pk_bf16(acc[pb][nb][0], acc[pb][nb][1]) : 0u; o.y = keep ? cvt_pk_bf16(acc[pb][nb][2], acc[pb][nb][3]) : 0u; *(u32x2*)(sec + (16 * pb + l15) * 128 + nq * 32 + 16 * nb + 4 * h) = o; }
        }
    }
}
__device__ __forceinline__ void sgu_unit(Frame& F, int l, int ci, int g) {
    const bf16_t* P = WSP(bf16_t, WS_P); bf16_t* Y = WSP(bf16_t, WS_Y);
    LAS bf16_t* VT = (LAS bf16_t*)F.lds; constexpr int VS = 136;
    const int t0 = chunk_t0(ci), w = F.wave, lane = F.lane, l15 = lane & 15, h = lane >> 4;
    __syncthreads();
    { const int row = F.tid >> 2, c0 = (F.tid & 3) * 32; const float ri = WSP(float, WS_RINV)[t0 + row];
      const float* gn = F.in[20] + (size_t)l * 1024 + g * 128 + c0;
#pragma unroll
      for (int j = 0; j < 4; ++j) { const u32x4 v = *(const u32x4*)(P + (size_t)(t0 + row) * LDP + PV + g * 128 + c0 + 8 * j);
          const f32x4 g0 = *(const f32x4*)(gn + 8 * j), g1 = *(const f32x4*)(gn + 8 * j + 4); u32x4 o;
          o.x = cvt_pk_bf16(bf_lo(v.x) * ri * g0[0], bf_hi(v.x) * ri * g0[1]); o.y = cvt_pk_bf16(bf_lo(v.y) * ri * g0[2], bf_hi(v.y) * ri * g0[3]);
          o.z = cvt_pk_bf16(bf_lo(v.z) * ri * g1[0], bf_hi(v.z) * ri * g1[1]); o.w = cvt_pk_bf16(bf_lo(v.w) * ri * g1[2], bf_hi(v.w) * ri * g1[3]);
          *(LAS u32x4*)(VT + row * VS + c0 + 8 * j) = o; } }
    __syncthreads();
    const bf16_t* Ws = WSP(bf16_t, WS_SGW) + ((size_t)(l * 8 + g) * 128 + 16 * w + l15) * 128 + 8 * h;
    v8s bw[4];
#pragma unroll
    for (int ks = 0; ks < 4; ++ks) bw[ks] = ld16(Ws + 32 * ks);
    const int q = 16 * w + l15; const float bq = F.in[22][(size_t)l * 1024 + g * 128 + q];
#pragma unroll 2
    for (int cb = 0; cb < 8; ++cb) {
        f32x4 acc = {0.f, 0.f, 0.f, 0.f};
#pragma unroll
        for (int ks = 0; ks < 4; ++ks) {
            const int rb = 32 * ks + 8 * h + (l15 >> 2), cc = 16 * cb + 4 * (lane & 3);
            const v4s t0v = __builtin_amdgcn_ds_read_tr16_b64_v4i16((LAS v4s*)(VT + rb * VS + cc));
            const v4s t1v = __builtin_amdgcn_ds_read_tr16_b64_v4i16((LAS v4s*)(VT + (rb + 4) * VS + cc));
            const v8s a = __builtin_shufflevector(t0v, t1v, 0, 1, 2, 3, 4, 5, 6, 7);
            acc = mma_bf(a, bw[ks], acc);
        }
        const size_t rowo = (size_t)(t0 + q);
        const u32x2 uu = *(const u32x2*)(P + rowo * LDP + PU + g * 128 + 16 * cb + 4 * h);
        u32x2 o; o.x = cvt_pk_bf16(bf_lo(uu.x) * (acc[0] + bq), bf_hi(uu.x) * (acc[1] + bq)); o.y = cvt_pk_bf16(bf_lo(uu.y) * (acc[2] + bq), bf_hi(uu.y) * (acc[3] + bq));
        *(u32x2*)(Y + rowo * D + 2048 + g * 128 + 16 * cb + 4 * h) = o;
    }
}

template <int NE>
__device__ __forceinline__ void scan_elems(Frame& F, const int (&e)[NE]) {
    const bf16_t* LS = WSP(bf16_t, WS_LS); const float* TOT = WSP(float, WS_TOT); bf16_t* SE = WSP(bf16_t, WS_SE);
    int d[NE], hd[NE], pn4[NE]; f32x4 S[NE];
#pragma unroll
    for (int j = 0; j < NE; ++j) { d[j] = e[j] >> 16; hd[j] = (e[j] >> 11) & 31; pn4[j] = e[j] & 2047; S[j] = (f32x4){0.f, 0.f, 0.f, 0.f}; }
#pragma unroll 1
    for (int s0 = 0; s0 < NCHK; s0 += 5) {
        f32x4 ls[NE][5]; float dc[NE][5]; size_t off[NE][5];
#pragma unroll
        for (int j = 0; j < NE; ++j)
#pragma unroll
            for (int k = 0; k < 5; ++k) { const int step = s0 + k; const int ci = d[j] == 0 ? step : (step < 2 ? 1 - step : 131 - step);
                off[j][k] = ((size_t)(d[j] * NCHK + ci) * 32 + hd[j]) * 8192 + (size_t)pn4[j] * 4; const u32x2 lv = *(const u32x2*)(LS + off[j][k]);
                ls[j][k] = (f32x4){bf_lo(lv.x), bf_hi(lv.x), bf_lo(lv.y), bf_hi(lv.y)}; dc[j][k] = TOT[(d[j] * NCHK + ci) * 32 + hd[j]]; }
#pragma unroll
        for (int j = 0; j < NE; ++j)
#pragma unroll
            for (int k = 0; k < 5; ++k) { u32x2 o; o.x = cvt_pk_bf16(S[j][0], S[j][1]); o.y = cvt_pk_bf16(S[j][2], S[j][3]); *(u32x2*)(SE + off[j][k]) = o; S[j] = S[j] * expf(dc[j][k]) + ls[j][k]; }
    }
}
__device__ __forceinline__ void scan_phase(Frame& F, int nskip) {
    const int b = (int)blockIdx.x;
    if (F.G != 256 || nskip == 0) { for (int e = b * NTHR + F.tid; e < 131072; e += F.G * NTHR) { const int ee[1] = {e}; scan_elems<1>(F, ee); } return; }
    if (b < nskip) return;
    const int e1 = (b - nskip) * NTHR + F.tid;
    if (b < 2 * nskip) { const int ee[2] = {e1, (256 - nskip) * NTHR + (b - nskip) * NTHR + F.tid}; scan_elems<2>(F, ee); }
    else { const int ee[1] = {e1}; scan_elems<1>(F, ee); }
}

struct PF8 { u32x4 x[2], s0[2], s1[2], z[2]; };
__device__ __forceinline__ void ssd_prefetch(PF8& pf, const bf16_t* XTc, const bf16_t* SE0, const bf16_t* SE1, const bf16_t* Pz, int hd, int tid, int lane) {
#pragma unroll
    for (int j = 0; j < 2; ++j) { const int id = tid + NTHR * j, row = id >> 4, c = (id & 15) * 8;
        pf.x[j] = *(const u32x4*)(XTc + (size_t)(hd * 64 + row) * NT + c);
        pf.s0[j] = *(const u32x4*)(SE0 + ((size_t)hd * 64 + row) * 128 + c); pf.s1[j] = *(const u32x4*)(SE1 + ((size_t)hd * 64 + row) * 128 + c); }
#pragma unroll
    for (int j = 0; j < 2; ++j) { const int id = lane + 64 * j, row = id >> 3, c = (id & 7) * 8; pf.z[j] = *(const u32x4*)(Pz + (size_t)row * LDP + hd * 64 + c); }
}
__device__ __forceinline__ void ssd_commit(const PF8& pf, LAS bf16_t* XTt, LAS bf16_t* SEt, LAS bf16_t* Zw, int tid, int lane) {
#pragma unroll
    for (int j = 0; j < 2; ++j) { const int id = tid + NTHR * j, row = id >> 4, c = (id & 15) * 8;
        *(LAS u32x4*)(XTt + row * 136 + c) = pf.x[j]; *(LAS u32x4*)(SEt + row * 136 + c) = pf.s0[j]; *(LAS u32x4*)(SEt + 64 * 136 + row * 136 + c) = pf.s1[j]; }
#pragma unroll
    for (int j = 0; j < 2; ++j) { const int id = lane + 64 * j, row = id >> 3, c = (id & 7) * 8; *(LAS u32x4*)(Zw + row * 72 + c) = pf.z[j]; }
}
__device__ __forceinline__ void ssd_out_unit(Frame& F, int l, int ci, int g, const bf16_t* SE0, const bf16_t* SE1) {
    const bf16_t* XC = WSP(bf16_t, WS_XC); const bf16_t* P = WSP(bf16_t, WS_P);
    const float* CS = WSP(float, WS_CS); const float* EIN = WSP(float, WS_EIN); const float* DT = WSP(float, WS_DT); bf16_t* Y = WSP(bf16_t, WS_Y);
    LAS float* csT = (LAS float*)F.lds;
    LAS float* dtT = csT + 2048;
    LAS float* eiT = csT + 4096;
    LAS bf16_t* XTt = (LAS bf16_t*)(F.lds + 24576);
    LAS bf16_t* SEt = XTt + 64 * 136;
    LAS bf16_t* Zw = (LAS bf16_t*)(F.lds + 24576 + 3 * 17408) + F.wave * (16 * 72);
    LAS float* RS = (LAS float*)(F.lds + 24576 + 3 * 17408 + 8 * 2304) + F.wave * 16;
    const int t0 = chunk_t0(ci), w = F.wave, lane = F.lane, l15 = lane & 15, h = lane >> 4;
    const bf16_t* XTc = WSP(bf16_t, WS_XT) + t0; const bf16_t* Pz = P + (size_t)(t0 + 16 * w) * LDP + PZ;
    PF8 pf;
    ssd_prefetch(pf, XTc, SE0, SE1, Pz, g * 8, F.tid, lane);
    LDS_BAR();
    for (int i = F.tid; i < 2048; i += NTHR) { const int d = i >> 10, r = (i >> 7) & 7, s = i & 127, hd = g * 8 + r; const size_t ix = ((size_t)d * NT + t0 + s) * 32 + hd;
        csT[i] = CS[ix]; eiT[i] = EIN[ix]; dtT[i] = DT[(size_t)(t0 + s) * 64 + d * 32 + hd]; }
    ssd_commit(pf, XTt, SEt, Zw, F.tid, lane);
    ssd_prefetch(pf, XTc, SE0, SE1, Pz, g * 8 + 1, F.tid, lane);
    v8s cf[4];
#pragma unroll
    for (int ks = 0; ks < 4; ++ks) cf[ks] = ld16(XC + (size_t)(t0 + 16 * w + l15) * 3072 + 2560 + g * 128 + 32 * ks + 8 * h);
    f32x4 cbt[8];
#pragma unroll
    for (int sb = 0; sb < 8; ++sb) { cbt[sb] = (f32x4){0.f, 0.f, 0.f, 0.f};
#pragma unroll
        for (int ks = 0; ks < 4; ++ks) cbt[sb] = mma_bf(ld16(XC + (size_t)(t0 + 16 * sb + l15) * 3072 + 2048 + g * 128 + 32 * ks + 8 * h), cf[ks], cbt[sb]); }
    float ss[4] = {0.f, 0.f, 0.f, 0.f};
    const int qa = 16 * w + l15;
    const int wh = w >> 1;
#pragma unroll 1
    for (int r = 0; r < 8; ++r) {
        LDS_BAR();
        const int hd = g * 8 + r;
        const float csq0 = csT[r * 128 + qa], csq1 = csT[(8 + r) * 128 + qa];
        f32x4 acc[4];
#pragma unroll
        for (int pb = 0; pb < 4; ++pb) acc[pb] = (f32x4){0.f, 0.f, 0.f, 0.f};
#pragma unroll
        for (int ks = 0; ks < 4; ++ks) {
            v8s bx[4];
#pragma unroll
            for (int pb = 0; pb < 4; ++pb) { const LAS bf16_t* xp = XTt + (16 * pb + l15) * 136 + 32 * ks + 4 * h; const v4s lo = *(const LAS v4s*)xp, hi = *(const LAS v4s*)(xp + 16); bx[pb] = __builtin_shufflevector(lo, hi, 0, 1, 2, 3, 4, 5, 6, 7); }
#pragma unroll
            for (int d = 0; d < 2; ++d) {
                const bool active = d == 0 ? (ks <= wh) : (ks >= wh);
                if (active) {
                    float e[8];
#pragma unroll
                    for (int hf = 0; hf < 2; ++hf) { const int sb = 2 * ks + hf, sbase = 16 * sb + 4 * h;
                        const f32x4 c4 = *(const LAS f32x4*)(csT + (d * 8 + r) * 128 + sbase), d4 = *(const LAS f32x4*)(dtT + (d * 8 + r) * 128 + sbase);
#pragma unroll
                        for (int i = 0; i < 4; ++i) { const int s = sbase + i; const bool ok = d == 0 ? (qa >= s) : (qa <= s);
                            const float arg = fminf((d == 0 ? csq0 : csq1) - c4[i], 0.f);
                            e[4 * hf + i] = ok ? cbt[sb][i] * __expf(arg) * d4[i] : 0.f; } }
                    const v8s af = pack8_bf(e[0], e[1], e[2], e[3], e[4], e[5], e[6], e[7]);
#pragma unroll
                    for (int pb = 0; pb < 4; ++pb) acc[pb] = mma_bf(af, bx[pb], acc[pb]);
                }
            }
        }
#pragma unroll
        for (int d = 0; d < 2; ++d) {
            const float eq = eiT[(d * 8 + r) * 128 + qa];
#pragma unroll
            for (int ks = 0; ks < 4; ++ks) { const u32x4 raw = __builtin_bit_cast(u32x4, cf[ks]);
                const v8s a = pack8_bf(bf_lo(raw.x) * eq, bf_hi(raw.x) * eq, bf_lo(raw.y) * eq, bf_hi(raw.y) * eq, bf_lo(raw.z) * eq, bf_hi(raw.z) * eq, bf_lo(raw.w) * eq, bf_hi(raw.w) * eq);
#pragma unroll
                for (int pb = 0; pb < 4; ++pb) acc[pb] = mma_bf(a, *(const LAS v8s*)(SEt + d * (64 * 136) + (16 * pb + l15) * 136 + 32 * ks + 8 * h), acc[pb]); }
        }
        const float dsk = F.in[18][l * 32 + hd];
#pragma unroll
        for (int pb = 0; pb < 4; ++pb) {
            const u32x2 x4 = *(const LAS u32x2*)(XTt + (16 * pb + l15) * 136 + 16 * w + 4 * h);
            const float xs[4] = {bf_lo(x4.x), bf_hi(x4.x), bf_lo(x4.y), bf_hi(x4.y)};
#pragma unroll
            for (int i = 0; i < 4; ++i) { const int ql = 4 * h + i; const float z = bf1(Zw[ql * 72 + 16 * pb + l15]);
                const float y = (acc[pb][i] + dsk * xs[i]) * z; ss[i] += y * y;
                Y[(size_t)(t0 + 16 * w + ql) * D + hd * 64 + 16 * pb + l15] = f2bf(y); }
        }
        LDS_BAR();
        if (r < 7) { ssd_commit(pf, XTt, SEt, Zw, F.tid, lane); if (r < 6) ssd_prefetch(pf, XTc, SE0, SE1, Pz, g * 8 + r + 2, F.tid, lane); }
    }
#pragma unroll
    for (int i = 0; i < 4; ++i) { float v = ss[i]; v += __shfl_xor(v, 1); v += __shfl_xor(v, 2); v += __shfl_xor(v, 4); v += __shfl_xor(v, 8);
        if (l15 == 0) RS[4 * h + i] = 1.0f / sqrtf(v * (1.0f / 512.0f) + EPS); }
    asm volatile("s_waitcnt vmcnt(0) lgkmcnt(0)" ::: "memory");
    { const float* gn = F.in[19] + (size_t)l * 2048 + g * 512 + lane * 8; const f32x4 g0 = *(const f32x4*)gn, g1 = *(const f32x4*)(gn + 4);
#pragma unroll 4
      for (int k = 0; k < 16; ++k) { bf16_t* yp = Y + (size_t)(t0 + 16 * w + k) * D + g * 512 + lane * 8; const u32x4 v = *(const u32x4*)yp; const float rk = RS[k]; u32x4 o;
          o.x = cvt_pk_bf16(bf_lo(v.x) * rk * g0[0], bf_hi(v.x) * rk * g0[1]); o.y = cvt_pk_bf16(bf_lo(v.y) * rk * g0[2], bf_hi(v.y) * rk * g0[3]);
          o.z = cvt_pk_bf16(bf_lo(v.z) * rk * g1[0], bf_hi(v.z) * rk * g1[1]); o.w = cvt_pk_bf16(bf_lo(v.w) * rk * g1[2], bf_hi(v.w) * rk * g1[3]);
          *(u32x4*)yp = o; } }
}

#ifndef SKIPM
#define SKIPM 0
#endif
#ifndef REPM
#define REPM 0
#endif
#ifndef REPA
#define REPA 0
#endif
#ifndef REPB
#define REPB 0
#endif
struct Args { const float* in[32]; float* out; unsigned char* ws; int ph_lo, ph_hi; };
constexpr int N_PHASES = 2 + 14 * NL + 1;

__global__ void __launch_bounds__(NTHR, 2) trunk_fwd(Args args) {
    extern __shared__ __attribute__((aligned(16))) unsigned char lds_raw[];
    Frame F;
    F.lds = (LAS unsigned char*)lds_raw; F.ws = args.ws; F.in = args.in; F.out = args.out;
    F.tid = threadIdx.x; F.lane = F.tid & 63; F.wave = __builtin_amdgcn_readfirstlane(F.tid >> 6);
    F.G = gridDim.x; F.gw = blockIdx.x * NWAVES + F.wave; F.NGW = F.G * NWAVES;
    volatile LAS unsigned* MISC = (volatile LAS unsigned*)(F.lds + LDS_MISC);
    if (F.tid < 64) MISC[F.tid] = 0u;
    __syncthreads();
    const int lo = args.ph_lo, hi = args.ph_hi;
    XcdBarrier bar; bar.bar = WSP(unsigned, WS_CTL) + 4096; bar.x = 0; bar.st = MISC + 8;
    if (hi - lo > 1) bar = xcd_barrier_post(WSP(unsigned, WS_CTL) + 4096, MISC + 8);
    int ph = 0;
#define PHASE_BEGIN if (lo <= ph && ph < hi) { { int _t = threadIdx.x; asm volatile("" : "+v"(_t)); F.tid = _t; F.lane = _t & 63; }
#define PHASE_END if (ph + 1 < hi) xcd_barrier(bar); } ++ph;

    PHASE_BEGIN for (int rep_ = 0; rep_ < 1 + ((REPM >> 0) & 1); ++rep_) if (!((SKIPM >> 0) & 1)) { prologue_a(F); } PHASE_END
    PHASE_BEGIN for (int rep_ = 0; rep_ < 1 + ((REPM >> 1) & 1); ++rep_) if (!((SKIPM >> 1) & 1)) { prologue_b(F); } PHASE_END

    float* CTXR = WSP(float, WS_CTXR);
#pragma unroll 1
    for (int l = 0; l < NL; ++l) {
        const bool last = (l == NL - 1);
        unsigned char* wl = F.ws + WS_W + (size_t)l * LW_SIZE;
        const int Mm = last ? NX : NT;
#pragma unroll 1
        for (int h = 0; h < 2; ++h) {
            const int Mh = h ? Mm : NT;
            PHASE_BEGIN { const bool first = (l == 0 && h == 0);
                norm_phase(F, first ? F.in[0] : F.out, first ? F.in[2] : CTXR, F.out, CTXR, first ? (const bf16_t*)nullptr : WSP(bf16_t, WS_DL), (h ? F.in[27] : F.in[7]) + (size_t)l * D, l, h ? 6 : 0, Mh,
                    CtxWork{h ? !last : l > 0, h ? WSP(bf16_t, WS_MG) : WSP(bf16_t, WS_A), (const bf16_t*)(h ? wl + LW_OUT : wl - LW_SIZE + LW_2B), h ? modv(F, l, 1, 5) : modv(F, l > 0 ? l - 1 : 0, 1, 8), h ? 1.0f : 0.5f,
                            WSP(unsigned, WS_CTL) + 16384 + 64 * (l * 3 + 2 * h)}); } PHASE_END
            PHASE_BEGIN { { pg8::Gemm g{WSP(bf16_t, WS_H), (const bf16_t*)(wl + (h ? LW_13B : LW_13A)), Mh, 2 * D, D}; pg8::StaticOrder S; S.init(Mh, 2 * D, F.G, (int)blockIdx.x);
                EpiSwiGLU E{WSP(bf16_t, WS_A)}; pg8::gemm_phase<EpiSwiGLU, pg8::StaticOrder, true, true>(F.lds, g, S, E); } convert_in_tail(F, l + 1, h ? CV_MRG : CV_PRO, h ? IL_ITEMS : CV_INP, ((Mh / 256) * 32) % F.G); } PHASE_END
            PHASE_BEGIN { { pg8::Gemm g{WSP(bf16_t, WS_A), (const bf16_t*)(wl + (h ? LW_2B : LW_2A)), NX, D, D}; pg8::StaticOrder S; S.init(NX, D, F.G, (int)blockIdx.x);
                EpiDelta E{WSP(bf16_t, WS_DL), modv(F, l, 0, h ? 8 : 2), modv(F, l, 1, h ? 8 : 2), 0.5f}; pg8::gemm_phase<EpiDelta, pg8::StaticOrder, true, true>(F.lds, g, S, E); } } PHASE_END
            if (h == 0) {
            PHASE_BEGIN for (int rep_ = 0; rep_ < 1 + ((REPM >> 5) & 1); ++rep_) if (!((SKIPM >> 5) & 1)) { norm_phase(F, l == 0 ? F.in[0] : F.out, l == 0 ? F.in[2] : CTXR, F.out, CTXR, WSP(bf16_t, WS_DL), F.in[11] + (size_t)l * D, l, 3, NT,
                    CtxWork{true, WSP(bf16_t, WS_A), (const bf16_t*)(wl + LW_2A), modv(F, l, 1, 2), 0.5f, WSP(unsigned, WS_CTL) + 16384 + 64 * (l * 3 + 1)}); } PHASE_END
            PHASE_BEGIN for (int rep_ = 0; rep_ < 1 + ((REPM >> 6) & 1); ++rep_) if (!((SKIPM >> 6) & 1)) { { pg8::Gemm g{WSP(bf16_t, WS_H), (const bf16_t*)(wl + LW_IN), NT, LDP, D}; pg8::StaticOrder S; S.init(NT, LDP, F.G, (int)blockIdx.x);
                EpiProj E{WSP(bf16_t, WS_P), WSP(float, WS_DT), WSP(float, WS_BIN) + (size_t)l * LDP}; pg8::gemm_phase<EpiProj, pg8::StaticOrder, true, true>(F.lds, g, S, E); } } PHASE_END
            PHASE_BEGIN for (int rep_ = 0; rep_ < 1 + ((REPM >> 7) & 1); ++rep_) if (!((SKIPM >> 7) & 1)) {
                for (int rr = 0; rr < 1 + (REPA & 1); ++rr) conv_all(F, l);
                for (int rr = 0; rr < 1 + ((REPA >> 1) & 1); ++rr) { for (int j = F.NGW - 1 - F.gw; j < NCHK * 8; j += F.NGW) cumsum_job(F, l, j);
                for (int t = (F.NGW - 1 - F.gw) * 4; t < NT; t += F.NGW * 4) vrms_job4(F, t); }
                fft_tables_to_lds(F, WSP(bf16_t, WS_TAB + TAB_CW), WSP(bf16_t, WS_TAB + TAB_SW));
                for (int rr = 0; rr < 1 + ((REPA >> 2) & 1); ++rr) for (int u = blockIdx.x; u < 1024; u += F.G) fft1_unit(F, u >> 6, (u >> 3) & 7, u & 7);
                __syncthreads();
                { const int u = (int)blockIdx.x - (F.G - 8); if (u >= 0 && u < 8) fft1c_unit(F, u); }
            } PHASE_END
            PHASE_BEGIN for (int rep_ = 0; rep_ < 1 + ((REPM >> 8) & 1); ++rep_) if (!((SKIPM >> 8) & 1)) {
                for (int rr = 0; rr < 1 + (REPB & 1); ++rr) {
                    for (int u = blockIdx.x; u < 1024; u += F.G) ssd_local_unit4(F, 2 + (u >> 3), (u & 7) * 4);
                    for (int u = F.G - 1 - (int)blockIdx.x; u < 16; u += F.G) ssd_local_unit4(F, u >> 3, (u & 7) * 4);
                    __syncthreads(); }
                for (int rr = 0; rr < 1 + ((REPB >> 1) & 1); ++rr) for (int u = ((int)blockIdx.x + F.G - 64) % F.G; u < NCHK * 8; u += F.G) sgu_unit(F, l, u >> 3, u & 7);
                fft_tables_to_lds(F, WSP(bf16_t, WS_TAB + TAB_CW), WSP(bf16_t, WS_TAB + TAB_SWN));
                for (int rr = 0; rr < 1 + ((REPB >> 2) & 1); ++rr) for (int u = blockIdx.x; u < 1024; u += F.G) fft2_unit(F, WSP(bf16_t, WS_GPR), WSP(bf16_t, WS_GPI), u >> 3, u & 7, 0, 128, 6.905339660024878e-4f);
                for (int u = ((int)blockIdx.x + F.G - 128) % F.G; u < 16; u += F.G) fft2_unit(F, WSP(bf16_t, WS_GPC), WSP(bf16_t, WS_GPC + MiB), u >> 3, u & 7, NX, 2, 5.524271728019903e-3f);
            } PHASE_END
            PHASE_BEGIN for (int rep_ = 0; rep_ < 1 + ((REPM >> 9) & 1); ++rep_) if (!((SKIPM >> 9) & 1)) { scan_phase(F, last ? 0 : 8);
                if (!last) for (int u = blockIdx.x; u < 8; u += F.G) ssd_out_unit(F, l, u >> 2, u & 3, WSP(bf16_t, WS_SEC) + (size_t)(0 * 2 + (u >> 2)) * 32 * 8192, WSP(bf16_t, WS_SEC) + (size_t)(1 * 2 + (u >> 2)) * 32 * 8192);
                __syncthreads(); } PHASE_END
            PHASE_BEGIN for (int rep_ = 0; rep_ < 1 + ((REPM >> 10) & 1); ++rep_) if (!((SKIPM >> 10) & 1)) {
                for (int u = blockIdx.x; u < 512; u += F.G) { const int ci = 2 + (u >> 2); ssd_out_unit(F, l, ci, u & 3, WSP(bf16_t, WS_SE) + (size_t)(0 * NCHK + ci) * 32 * 8192, WSP(bf16_t, WS_SE) + (size_t)(1 * NCHK + ci) * 32 * 8192); }
                __syncthreads();
            } PHASE_END
            PHASE_BEGIN for (int rep_ = 0; rep_ < 1 + ((REPM >> 11) & 1); ++rep_) if (!((SKIPM >> 11) & 1)) { { pg8::Gemm g{WSP(bf16_t, WS_Y), (const bf16_t*)(wl + LW_BR), Mm, D, D}; pg8::StaticOrder S; S.init(Mm, D, F.G, (int)blockIdx.x);
                EpiMerge E{WSP(bf16_t, WS_P), WSP(bf16_t, WS_MG)}; pg8::gemm_phase<EpiMerge, pg8::StaticOrder, true, true>(F.lds, g, S, E); } convert_in_tail(F, l + 1, CV_INP, CV_MRG, ((Mm / 256) * 16) % F.G); } PHASE_END
            PHASE_BEGIN for (int rep_ = 0; rep_ < 1 + ((REPM >> 12) & 1); ++rep_) if (!((SKIPM >> 12) & 1)) { { pg8::Gemm g{WSP(bf16_t, WS_MG), (const bf16_t*)(wl + LW_OUT), NX, D, D}; pg8::StaticOrder S; S.init(NX, D, F.G, (int)blockIdx.x);
                EpiDelta E{WSP(bf16_t, WS_DL), modv(F, l, 0, 5), modv(F, l, 1, 5), 1.0f}; pg8::gemm_phase<EpiDelta, pg8::StaticOrder, true, true>(F.lds, g, S, E); } } PHASE_END
            }
        }
    }
    PHASE_BEGIN for (int rep_ = 0; rep_ < 1 + ((REPM >> 16) & 1); ++rep_) if (!((SKIPM >> 16) & 1)) { final_norm_phase(F, WSP(bf16_t, WS_DL), F.in[31]); } PHASE_END
#undef PHASE_BEGIN
#undef PHASE_END
}

extern "C" void kernel_launch(void* const* d_in, const int* in_sizes, int n_in, void* d_out, int out_size, void* d_ws, size_t ws_size, hipStream_t stream) {
    static int grid = 0;
    if (grid == 0) {
        if (n_in != 32 || out_size != NX * D || ws_size < WS_END) { fprintf(stderr, "kernel_launch: unexpected shapes (n_in %d, out %d, ws %zu < %zu)\n", n_in, out_size, ws_size, (size_t)WS_END); grid = -1; return; }
        int dev = 0, cus = 0;
        if (hipGetDevice(&dev) != hipSuccess || hipDeviceGetAttribute(&cus, hipDeviceAttributeMultiprocessorCount, dev) != hipSuccess) { grid = -1; return; }
        if (hipFuncSetAttribute((const void*)trunk_fwd, hipFuncAttributeMaxDynamicSharedMemorySize, LDS_BYTES) != hipSuccess) { fprintf(stderr, "kernel_launch: hipFuncSetAttribute failed\n"); grid = -1; return; }
        int per_cu = 0;
        if (hipOccupancyMaxActiveBlocksPerMultiprocessor(&per_cu, (const void*)trunk_fwd, NTHR, LDS_BYTES) != hipSuccess || per_cu < 1) { fprintf(stderr, "kernel_launch: occupancy query says %d\n", per_cu); }
        (void)hipGetLastError();
        grid = cus;
    }
    if (grid < 0) return;
    (void)in_sizes;
    hipMemsetAsync((char*)d_ws + WS_CTL, 0, MiB, stream);
    Args a{};
    for (int i = 0; i < 32; ++i) a.in[i] = (const float*)d_in[i];
    a.out = (float*)d_out; a.ws = (unsigned char*)d_ws;
#if MK_SPLIT
    for (int p = 0; p < N_PHASES; ++p) { a.ph_lo = p; a.ph_hi = p + 1; hipLaunchKernelGGL(trunk_fwd, dim3(grid), dim3(NTHR), LDS_BYTES, stream, a); }
#else
    a.ph_lo = 0; a.ph_hi = N_PHASES;
    hipLaunchKernelGGL(trunk_fwd, dim3(grid), dim3(NTHR), LDS_BYTES, stream, a);
#endif
}
```

```cpp
#include <hip/hip_runtime.h>
#include <cstdio>
#include <cstdint>

#ifndef MK_SPLIT
#define MK_SPLIT 0
#endif

namespace pg8 {
#define PG8_LAS __attribute__((address_space(3)))
typedef unsigned short bf16_t;
typedef short bf16x8 __attribute__((ext_vector_type(8)));
typedef float f32x4 __attribute__((ext_vector_type(4)));
typedef unsigned u32x4 __attribute__((ext_vector_type(4)));
constexpr int BM = 256, BK = 64, HALF = 128, HTB = HALF * BK * 2  , STAGE_BYTES = 8 * HTB, NXCD = 8, WGM = 8;

__host__ __device__ __forceinline__ int lds_byte(int r, int c) { const int st = (r >> 4) * 2 + (c >> 5), rr = r & 15, cc = c & 31, ob = rr * 64 + cc * 2; return st * 1024 + (ob ^ (((ob >> 9) & 1) << 5)); }
__host__ __device__ __forceinline__ void stage_rc(int b, int& R, int& C) { const int st = b / 1024, sb = b % 1024, swz = sb ^ (((sb >> 9) & 1) << 5); R = (st >> 1) * 16 + swz / 64; C = (st & 1) * 32 + (swz % 64) / 2; }
__host__ __device__ __forceinline__ int perm32(int rho) { const int n = rho >> 4, i = rho & 15; return 8 * (i >> 2) + 4 * n + (i & 3); }

struct Unit { int pm, pn; };
struct Gemm { const bf16_t* A; const bf16_t* Bt; int M, N, K; int ld = 0; };

struct StaticOrder {
    int nM, nN, nwg, G, c;
    __host__ __device__ void init(int M, int N, int G_, int c_) { nM = M / BM; nN = N / BM; nwg = nM * nN; G = G_; c = c_; }
    __host__ __device__ bool next(int i, Unit& u) const {
        const long L = (long)i * G + c; if (L >= nwg) return false;
        int wgid = (int)L; { const int q = nwg / NXCD, r = nwg % NXCD, xcd = wgid % NXCD, off = wgid / NXCD; wgid = (xcd < r ? xcd * (q + 1) : r * (q + 1) + (xcd - r) * q) + off; }
        const int nig = WGM * nN, gid = wgid / nig, fm = gid * WGM, gsz = (nM - fm) < WGM ? (nM - fm) : WGM;
        u.pm = fm + ((wgid % nig) % gsz); u.pn = (wgid % nig) / gsz; return true;
    }
    __device__ __forceinline__ void a_ready(const Unit&) const {}
    __device__ __forceinline__ void done(const Unit&) const {}
};
template <class Epi, class Sched, bool ALIGN_EPI = false, bool SP2 = false>
__device__ __forceinline__ void gemm_phase(PG8_LAS unsigned char* lds, const Gemm g, const Sched& S, const Epi& E) {
    int tid_ = threadIdx.x; asm volatile("" : "+v"(tid_));   const int tid = tid_, wid = __builtin_amdgcn_readfirstlane(tid >> 6), lane = tid & 63, wr = wid >> 2, wc = wid & 3, fr = lane & 15, fq = lane >> 4;
    const int K = g.K, nt = K / BK, LD = g.ld ? g.ld : g.K;
    unsigned voffA[2], voffB[2];
#pragma unroll
    for (int i = 0; i < 2; ++i) { int R, C; stage_rc(tid * 16 + i * 8192, R, C); const int Rb = Epi::PERM ? ((R & ~31) + perm32(R & 31)) : R;
        voffA[i] = (unsigned)(R * LD + C) * 2u; voffB[i] = (unsigned)(Rb * LD + C) * 2u; }
    const size_t kstep = (size_t)(BK * 2);
    const size_t hstep = (size_t)HALF * LD * 2;
    const size_t tstep = 2 * hstep;
    const unsigned ldsw = (unsigned)wid * 1024u;
    const int aoff = lds_byte(wr * 64 + fr, fq * 8), boff = lds_byte(wc * 32 + fr, fq * 8);
#define PG8_SA(b, h) (((b) * 2 + (h)) * HTB)
#define PG8_SB(b, h) ((4 + (b) * 2 + (h)) * HTB)
#define PG8_STAGE(bufoff, gbase, voff) do { _Pragma("unroll") for (int _i = 0; _i < 2; ++_i) \
        __builtin_amdgcn_global_load_lds((const unsigned*)((const char*)(gbase) + (voff)[_i]), (PG8_LAS unsigned*)(lds + (bufoff) + ldsw + _i * 8192), 16, 0, 0); } while (0)
#define PG8_LDA(dst, b, h) do { _Pragma("unroll") for (int m = 0; m < 4; ++m) _Pragma("unroll") for (int k = 0; k < 2; ++k) dst[m][k] = *(const PG8_LAS bf16x8*)(lds + PG8_SA(b, h) + aoff + m * 2048 + k * 1024); } while (0)
#define PG8_LDB(dst, b, h) do { _Pragma("unroll") for (int n = 0; n < 2; ++n) _Pragma("unroll") for (int k = 0; k < 2; ++k) dst[n][k] = *(const PG8_LAS bf16x8*)(lds + PG8_SB(b, h) + boff + n * 2048 + k * 1024); } while (0)
#define PG8_MMA(ai, bj, At, Bt) do { __builtin_amdgcn_s_setprio(1); _Pragma("unroll") for (int m = 0; m < 4; ++m) _Pragma("unroll") for (int n = 0; n < 2; ++n) _Pragma("unroll") for (int k = 0; k < 2; ++k) \
        acc[ai][bj][m][n] = __builtin_amdgcn_mfma_f32_16x16x32_bf16(Bt[n][k], At[m][k], acc[ai][bj][m][n], 0, 0, 0); __builtin_amdgcn_s_setprio(0); } while (0)
#define PG8_WAIT_V(n) asm volatile("s_waitcnt vmcnt(" #n ")" ::: "memory")
#define PG8_WAIT_L(n) asm volatile("s_waitcnt lgkmcnt(" #n ")" ::: "memory")
#define PG8_BAR __builtin_amdgcn_s_barrier()
#define PG8_SCHED __builtin_amdgcn_sched_barrier(0)
    Unit cur, nxt; int ui = 0;
    if (!S.next(0, cur)) return;
    f32x4 acc[2][2][4][2];
#pragma unroll
    for (int a = 0; a < 2; ++a)
#pragma unroll
        for (int b = 0; b < 2; ++b)
#pragma unroll
            for (int m = 0; m < 4; ++m)
#pragma unroll
                for (int n = 0; n < 2; ++n) acc[a][b][m][n] = (f32x4){0.f, 0.f, 0.f, 0.f};
    bf16x8 At[4][2], B0[2][2], B1[2][2];
    typename Epi::Pre pre; E.pre_init(pre);
    const char* cA = (const char*)g.A + (size_t)cur.pm * tstep; const char* cB = (const char*)g.Bt + (size_t)cur.pn * tstep;
    S.a_ready(cur);
    if constexpr (SP2) {
        PG8_STAGE(PG8_SB(0, 0), cB, voffB); PG8_STAGE(PG8_SB(0, 1), cB + hstep, voffB); PG8_STAGE(PG8_SA(0, 0), cA, voffA); PG8_STAGE(PG8_SA(0, 1), cA + hstep, voffA);
        if (wr == 1) PG8_BAR;
        PG8_WAIT_V(2); PG8_BAR;
        PG8_STAGE(PG8_SB(1, 0), cB + kstep, voffB); PG8_STAGE(PG8_SA(1, 0), cA + kstep, voffA); PG8_STAGE(PG8_SB(1, 1), cB + hstep + kstep, voffB);
        PG8_WAIT_V(6); PG8_BAR;
    } else {
        PG8_STAGE(PG8_SB(0, 0), cB, voffB); PG8_STAGE(PG8_SA(0, 0), cA, voffA); PG8_STAGE(PG8_SB(0, 1), cB + hstep, voffB); PG8_STAGE(PG8_SA(0, 1), cA + hstep, voffA);
        if (wr == 1) PG8_BAR;
        PG8_WAIT_V(4); PG8_BAR;
        PG8_STAGE(PG8_SB(1, 0), cB + kstep, voffB); PG8_STAGE(PG8_SA(1, 0), cA + kstep, voffA); PG8_STAGE(PG8_SB(1, 1), cB + hstep + kstep, voffB);
        PG8_WAIT_V(6); PG8_BAR;
    }
    for (;;) {
        const bool has_next = S.next(ui + 1, nxt);
        const char* nA = has_next ? (const char*)g.A + (size_t)nxt.pm * tstep : cA; const char* nB = has_next ? (const char*)g.Bt + (size_t)nxt.pn * tstep : cB;
        for (int t = 0; t < nt; t += 2) {
            const bool last = (t == nt - 2);
            const char* a1 = cA + (size_t)(t + 1) * kstep;
            const char* a2 = last ? nA : cA + (size_t)(t + 2) * kstep; const char* b2 = last ? nB : cB + (size_t)(t + 2) * kstep;
            const char* a3 = a2 + kstep; const char* b3 = b2 + kstep;
            if (last && has_next) S.a_ready(nxt);
            if (last) E.prefetch(pre, cur, wr, wc, fr, fq);
            if constexpr (Epi::KHOOK) { if (t == Epi::H1 || t == Epi::H2) E.khook(acc, cur, t, wr, wc, fr, fq); }
            if constexpr (SP2) {
            PG8_LDB(B0, 0, 0); PG8_LDB(B1, 0, 1); PG8_SCHED; PG8_LDA(At, 0, 0); PG8_STAGE(PG8_SA(1, 1), a1 + hstep, voffA);
            PG8_WAIT_V(8); PG8_WAIT_L(0); PG8_BAR; PG8_MMA(0, 0, At, B0); PG8_MMA(0, 1, At, B1); PG8_BAR; PG8_SCHED;
            PG8_LDA(At, 0, 1); PG8_STAGE(PG8_SB(0, 0), b2, voffB); PG8_STAGE(PG8_SB(0, 1), b2 + hstep, voffB); PG8_STAGE(PG8_SA(0, 0), a2, voffA);
            PG8_WAIT_V(8); PG8_WAIT_L(0); PG8_BAR; PG8_MMA(1, 0, At, B0); PG8_MMA(1, 1, At, B1); PG8_BAR; PG8_SCHED;
            PG8_LDB(B0, 1, 0); PG8_LDB(B1, 1, 1); PG8_SCHED; PG8_LDA(At, 1, 0); PG8_STAGE(PG8_SA(0, 1), a2 + hstep, voffA);
            PG8_WAIT_V(8); PG8_WAIT_L(0); PG8_BAR; PG8_MMA(0, 0, At, B0); PG8_MMA(0, 1, At, B1); PG8_BAR; PG8_SCHED;
            PG8_LDA(At, 1, 1); PG8_STAGE(PG8_SB(1, 0), b3, voffB); PG8_STAGE(PG8_SB(1, 1), b3 + hstep, voffB); PG8_STAGE(PG8_SA(1, 0), a3, voffA);
            PG8_WAIT_V(8); PG8_WAIT_L(0); PG8_BAR; PG8_MMA(1, 0, At, B0); PG8_MMA(1, 1, At, B1); PG8_BAR; PG8_SCHED;
            } else {
            PG8_LDB(B0, 0, 0); PG8_SCHED; PG8_LDA(At, 0, 0); PG8_STAGE(PG8_SA(1, 1), a1 + hstep, voffA);
            PG8_WAIT_L(8); PG8_BAR; PG8_WAIT_L(0); PG8_MMA(0, 0, At, B0); PG8_BAR; PG8_SCHED;
            PG8_LDB(B1, 0, 1); PG8_STAGE(PG8_SB(0, 0), b2, voffB);
            PG8_BAR; PG8_WAIT_L(0); PG8_MMA(0, 1, At, B1); PG8_BAR;
            PG8_LDA(At, 0, 1); PG8_STAGE(PG8_SA(0, 0), a2, voffA);
            PG8_BAR; PG8_WAIT_L(0); PG8_MMA(1, 0, At, B0); PG8_BAR; PG8_SCHED;
            PG8_STAGE(PG8_SB(0, 1), b2 + hstep, voffB);
            PG8_WAIT_V(6); PG8_BAR; PG8_MMA(1, 1, At, B1); PG8_BAR;
            PG8_LDB(B0, 1, 0); PG8_SCHED; PG8_LDA(At, 1, 0); PG8_STAGE(PG8_SA(0, 1), a2 + hstep, voffA);
            PG8_WAIT_L(8); PG8_BAR; PG8_WAIT_L(0); PG8_MMA(0, 0, At, B0); PG8_BAR; PG8_SCHED;
            PG8_LDB(B1, 1, 1); PG8_STAGE(PG8_SB(1, 0), b3, voffB);
            PG8_BAR; PG8_WAIT_L(0); PG8_MMA(0, 1, At, B1); PG8_BAR;
            PG8_LDA(At, 1, 1); PG8_STAGE(PG8_SA(1, 0), a3, voffA);
            PG8_BAR; PG8_WAIT_L(0); PG8_MMA(1, 0, At, B0); PG8_BAR; PG8_SCHED;
            PG8_STAGE(PG8_SB(1, 1), b3 + hstep, voffB);
            PG8_WAIT_V(6); PG8_BAR; PG8_MMA(1, 1, At, B1); PG8_BAR;
            }
        }
        if constexpr (ALIGN_EPI) { if (wr == 0) PG8_BAR; }
        if constexpr (!Epi::AFTER_DRAIN) { E(acc, cur, wr, wc, fr, fq, pre); S.done(cur); }
        if (!has_next) break;
#pragma unroll
        for (int a = 0; a < 2; ++a)
#pragma unroll
            for (int b = 0; b < 2; ++b)
#pragma unroll
                for (int m = 0; m < 4; ++m)
#pragma unroll
                    for (int n = 0; n < 2; ++n) acc[a][b][m][n] = (f32x4){0.f, 0.f, 0.f, 0.f};
        cur = nxt; cA = nA; cB = nB; ++ui;
        if constexpr (ALIGN_EPI) { if (wr == 1) PG8_BAR; }
    }
    PG8_WAIT_V(0);
    if constexpr (!ALIGN_EPI) { if (wr == 0) PG8_BAR; }
    PG8_BAR;
    if constexpr (Epi::AFTER_DRAIN) { E.fused(acc, cur, wr, wc, fr, fq, lds, wid, lane); S.done(cur); }
#undef PG8_SA
#undef PG8_SB
#undef PG8_STAGE
#undef PG8_LDA
#undef PG8_LDB
#undef PG8_MMA
#undef PG8_WAIT_V
#undef PG8_WAIT_L
#undef PG8_BAR
#undef PG8_SCHED
}
}

constexpr int D = 4096, NX = 16384, NCX = 256, NT = NX + NCX, NL = 4;
constexpr int NCHK = 130;
constexpr int LDP = 20736;
constexpr int PZ = 0, PXBC = 2048, PU = 5120, PV = 6144, PF = 7168, PG = 8192, PDT = 20480;
constexpr float EPS = 1e-6f;
constexpr int NWAVES = 8, NTHR = 512;
#ifndef KHOOK_ON
#define KHOOK_ON true
#endif

constexpr size_t MiB = 1u << 20;
constexpr size_t WS_CTL = 0;
constexpr size_t WS_MOD = 1 * MiB;
constexpr size_t WS_T1 = 3 * MiB;
constexpr size_t WS_BIN = 4 * MiB;
constexpr size_t WS_TAB = 5 * MiB;
constexpr size_t TAB_CW = 0, TAB_SW = 32768, TAB_SWN = 65536, TAB_TW = 98304, TAB_TWC = 98304 + 131072;
constexpr size_t WS_SGW = 6 * MiB;
constexpr size_t WS_DT = 7 * MiB;
constexpr size_t WS_CS = 12 * MiB;
constexpr size_t WS_EIN = 17 * MiB;
constexpr size_t WS_WEND = 22 * MiB;
constexpr size_t WS_TOT = 27 * MiB;
constexpr size_t WS_RINV = 27 * MiB + 256 * 1024;
constexpr size_t WS_CTXR = 27 * MiB + 512 * 1024;
constexpr size_t WS_SEC = 31 * MiB + 512 * 1024;
constexpr size_t WS_GPC = 33 * MiB + 512 * 1024;
constexpr size_t WS_W = 36 * MiB;
constexpr size_t LW_13A = 0, LW_2A = 64 * MiB, LW_IN = 96 * MiB, LW_BR = 258 * MiB, LW_OUT = 290 * MiB, LW_13B = 322 * MiB, LW_2B = 386 * MiB, LW_SIZE = 418 * MiB;
constexpr size_t WS_H = WS_W + NL * LW_SIZE;
constexpr size_t WS_A = WS_H + 130 * MiB;
constexpr size_t WS_P = WS_A + 130 * MiB;
constexpr size_t WS_XC = WS_P + 659 * MiB;
constexpr size_t WS_XT = WS_XC + 98 * MiB;
constexpr size_t WS_Y = WS_XT + 82 * MiB;
constexpr size_t WS_MG = WS_Y + 130 * MiB;
constexpr size_t WS_LS = WS_MG + 130 * MiB;
constexpr size_t WS_SE = WS_LS + 260 * MiB;
constexpr size_t WS_GPR = WS_SE + 130 * MiB;
constexpr size_t WS_GPI = WS_GPR + 32 * MiB;
constexpr size_t WS_DL = WS_GPI + 32 * MiB;
constexpr size_t WS_DL2 = WS_DL + 130 * MiB;
constexpr size_t WS_END = WS_DL2 + 130 * MiB;
static_assert((size_t)NT * LDP * 2 <= 659 * MiB && (size_t)20736 * 4096 * 2 == 162 * MiB, "map");

constexpr int LDS_BYTES = 155648;
constexpr int LDS_MISC = 151552;

#define LAS __attribute__((address_space(3)))
typedef unsigned short bf16_t;
typedef short v8s __attribute__((ext_vector_type(8)));
typedef short v4s __attribute__((ext_vector_type(4)));
typedef _Float16 v8h __attribute__((ext_vector_type(8)));
typedef _Float16 v2h __attribute__((ext_vector_type(2)));
typedef float f32x4 __attribute__((ext_vector_type(4)));
typedef float f32x2 __attribute__((ext_vector_type(2)));
typedef unsigned u32x4 __attribute__((ext_vector_type(4)));
typedef unsigned u32x2 __attribute__((ext_vector_type(2)));

__device__ __forceinline__ unsigned cvt_pk_bf16(float lo, float hi) { unsigned r; asm volatile("v_cvt_pk_bf16_f32 %0, %1, %2" : "=v"(r) : "v"(lo), "v"(hi)); return r; }
__device__ __forceinline__ float bf_lo(unsigned u) { return __uint_as_float(u << 16); }
__device__ __forceinline__ float bf_hi(unsigned u) { return __uint_as_float(u & 0xffff0000u); }
__device__ __forceinline__ float bf1(bf16_t b) { return __uint_as_float(((unsigned)b) << 16); }
__device__ __forceinline__ bf16_t f2bf(float f) { return (bf16_t)(cvt_pk_bf16(f, 0.f) & 0xffffu); }
__device__ __forceinline__ unsigned pk_f16(float a, float b) { v2h v = {(_Float16)a, (_Float16)b}; return __builtin_bit_cast(unsigned, v); }
__device__ __forceinline__ bf16_t f2h(float a) { _Float16 h = (_Float16)a; return __builtin_bit_cast(unsigned short, h); }
__device__ __forceinline__ f32x4 mma_bf(v8s a, v8s b, f32x4 c) { return __builtin_amdgcn_mfma_f32_16x16x32_bf16(a, b, c, 0, 0, 0); }
__device__ __forceinline__ f32x4 mma_h(v8s a, v8s b, f32x4 c) { return __builtin_amdgcn_mfma_f32_16x16x32_f16(__builtin_bit_cast(v8h, a), __builtin_bit_cast(v8h, b), c, 0, 0, 0); }
__device__ __forceinline__ v8s ld16(const bf16_t* p) { return *(const v8s*)p; }
__device__ __forceinline__ v8s ld8x2(const bf16_t* p0, const bf16_t* p1) { const v4s a = *(const v4s*)p0, b = *(const v4s*)p1; return __builtin_shufflevector(a, b, 0, 1, 2, 3, 4, 5, 6, 7); }
__device__ __forceinline__ v8s pack8_bf(float e0, float e1, float e2, float e3, float e4, float e5, float e6, float e7) {
    u32x4 w; w.x = cvt_pk_bf16(e0, e1); w.y = cvt_pk_bf16(e2, e3); w.z = cvt_pk_bf16(e4, e5); w.w = cvt_pk_bf16(e6, e7); return __builtin_bit_cast(v8s, w); }
__device__ __forceinline__ v8s pack8_h(float e0, float e1, float e2, float e3, float e4, float e5, float e6, float e7) {
    u32x4 w; w.x = pk_f16(e0, e1); w.y = pk_f16(e2, e3); w.z = pk_f16(e4, e5); w.w = pk_f16(e6, e7); return __builtin_bit_cast(v8s, w); }
__device__ __forceinline__ float wave_sum(float v) {
#pragma unroll
    for (int o = 1; o < 64; o <<= 1) v += __shfl_xor(v, o);
    return v;
}
__device__ __forceinline__ float silu_f(float x) { return x * __builtin_amdgcn_rcpf(1.0f + __expf(-x)); }
__device__ __forceinline__ float sigm_f(float x) { return __builtin_amdgcn_rcpf(1.0f + __expf(-x)); }
__device__ __forceinline__ float gelu_f(float x) { const float u = 0.7978845608028654f * (x + 0.044715f * x * x * x); return x * __builtin_amdgcn_rcpf(1.0f + __expf(-2.0f * u)); }
__device__ __forceinline__ float softplus_f(float x) { return fmaxf(x, 0.f) + log1pf(expf(-fabsf(x))); }
__device__ __forceinline__ int chunk_t0(int ci) { return ci < 2 ? NX + 128 * ci : 128 * (ci - 2); }
#define LDS_WAIT() asm volatile("s_waitcnt lgkmcnt(0)" ::: "memory")
#define LDS_BAR() do { asm volatile("s_waitcnt lgkmcnt(0)" ::: "memory"); __builtin_amdgcn_s_barrier(); asm volatile("" ::: "memory"); } while (0)

#define XB_TMO      128
#define XB_XCNT(j)  (256  + 64 * (j))
#define XB_XSUB(j)  (1280 + 64 * (j))
#define XB_XGEN(j)  (2304 + 64 * (j))
#define XB_TOP      3328
#define XB_TOPGEN   3392
#define XCD_BAR_WORDS 3456
#define XB_SPIN_CAP (1u << 18)
__device__ __forceinline__ unsigned xb_ld(unsigned* p)              { return __hip_atomic_load(p, __ATOMIC_RELAXED, __HIP_MEMORY_SCOPE_AGENT); }
__device__ __forceinline__ unsigned xb_add(unsigned* p, unsigned v) { return __hip_atomic_fetch_add(p, v, __ATOMIC_RELAXED, __HIP_MEMORY_SCOPE_AGENT); }
__device__ __forceinline__ unsigned xb_xcc_id() { return (unsigned)__builtin_amdgcn_s_getreg((3 << 11) | 20) & 0xFu; }
#define XB_SPIN(cond, bar) do { unsigned _sp = 0; while (cond) { __builtin_amdgcn_s_sleep(1); \
    if ((++_sp & 255u) == 0u) { if (xb_ld(&(bar)[XB_TMO])) break; if (_sp > XB_SPIN_CAP) { atomicAdd(&(bar)[XB_TMO], 1u); break; } } } } while (0)
struct XcdBarrier { unsigned* bar; unsigned x; volatile LAS unsigned* st; };
__device__ __forceinline__ XcdBarrier xcd_barrier_post(unsigned* bar, volatile LAS unsigned* st) {
    XcdBarrier b; b.bar = bar; b.x = xb_xcc_id(); b.st = st;
    if (threadIdx.x == 0) (void)xb_add(&bar[XB_XCNT(b.x)], 1u);
    return b;
}
__device__ __forceinline__ void xcd_barrier_complete(unsigned* bar, unsigned x, unsigned& nloc, unsigned& nx) {
    const unsigned G = gridDim.x * gridDim.y * gridDim.z;
    unsigned sum, cnt, mine, sp = 0u;
    for (;;) {
        sum = 0u; cnt = 0u; mine = 0u;
#pragma unroll
        for (unsigned j = 0; j < 16; ++j) { const unsigned c = xb_ld(&bar[XB_XCNT(j)]); sum += c; cnt += (c > 0u) ? 1u : 0u; mine = (j == x) ? c : mine; }
        if (sum == G) break;
        __builtin_amdgcn_s_sleep(1);
        if ((++sp & 255u) == 0u) { if (xb_ld(&bar[XB_TMO])) break; if (sp > XB_SPIN_CAP) { atomicAdd(&bar[XB_TMO], 1u); break; } }
    }
    nloc = mine > 0u ? mine : 1u; nx = cnt > 0u ? cnt : 1u;
}
__device__ __forceinline__ void xcd_barrier(const XcdBarrier& b) {
    asm volatile("s_waitcnt vmcnt(0)" ::: "memory");
    __syncthreads();
    if (threadIdx.x == 0) {
        unsigned* bar = b.bar;
        __builtin_amdgcn_s_waitcnt(0);
        unsigned nloc = b.st[0], nx = b.st[1];
        if (nloc == 0u) { xcd_barrier_complete(bar, b.x, nloc, nx); b.st[0] = nloc; b.st[1] = nx; }
        const unsigned old = xb_add(&bar[XB_XSUB(b.x)], 1u);
        const unsigned gen = old / nloc;
        if (old + 1u == (gen + 1u) * nloc) {
            __builtin_amdgcn_fence(__ATOMIC_RELEASE, "agent");
            asm volatile("s_waitcnt vmcnt(0)" ::: "memory");
            const unsigned og = xb_add(&bar[XB_TOP], 1u);
            const unsigned tg = og / nx;
            if (og + 1u == (tg + 1u) * nx) xb_add(&bar[XB_TOPGEN], 1u);
            else XB_SPIN(xb_ld(&bar[XB_TOPGEN]) == tg, bar);
            __builtin_amdgcn_fence(__ATOMIC_ACQUIRE, "agent");
            xb_add(&bar[XB_XGEN(b.x)], 1u);
            asm volatile("s_waitcnt vmcnt(0)" ::: "memory");
        } else {
            XB_SPIN(xb_ld(&bar[XB_XGEN(b.x)]) == gen, bar);
            __builtin_amdgcn_fence(__ATOMIC_ACQUIRE, "agent");
            asm volatile("s_waitcnt vmcnt(0)" ::: "memory");
        }
    }
    __syncthreads();
}

struct Frame {
    LAS unsigned char* lds;
    unsigned char* ws;
    const float* const* in;
    float* out;
    int tid, lane, wave, G, gw, NGW;
};
#define WSP(T, off) ((T*)(F.ws + (off)))

using pg8::Unit;
struct EpiSwiGLU {
    static constexpr bool PERM = true, AFTER_DRAIN = false, KHOOK = false; static constexpr int H1 = -1, H2 = -1;
    bf16_t* O;
    struct Pre {};
    __device__ __forceinline__ void pre_init(Pre&) const {}
    __device__ __forceinline__ void prefetch(Pre&, const Unit&, int, int, int, int) const {}
    __device__ __forceinline__ void khook(f32x4 (&)[2][2][4][2], const Unit&, int, int, int, int, int) const {}
    __device__ __forceinline__ void operator()(const f32x4 (&acc)[2][2][4][2], const Unit& u, int wr, int wc, int fr, int fq, const Pre&) const {
        const int row0 = u.pm * 256 + wr * 64 + fr, col0 = u.pn * 128 + wc * 32 + 8 * fq;
#pragma unroll
        for (int ai = 0; ai < 2; ++ai)
#pragma unroll
            for (int m = 0; m < 4; ++m) {
                float o[8];
#pragma unroll
                for (int n = 0; n < 2; ++n)
#pragma unroll
                    for (int j = 0; j < 4; ++j) o[4 * n + j] = silu_f(acc[ai][0][m][n][j]) * acc[ai][1][m][n][j];
                u32x4 w; w.x = cvt_pk_bf16(o[0], o[1]); w.y = cvt_pk_bf16(o[2], o[3]); w.z = cvt_pk_bf16(o[4], o[5]); w.w = cvt_pk_bf16(o[6], o[7]);
                *(u32x4*)(O + (size_t)(row0 + ai * 128 + m * 16) * D + col0) = w;
            }
    }
};
struct EpiDelta {
    static constexpr bool PERM = true, AFTER_DRAIN = false, KHOOK = false; static constexpr int H1 = -1, H2 = -1;
    bf16_t* O; const float* coefx; const float* coefc; float scale;
    struct Pre { f32x4 cv[2][2]; };
    __device__ __forceinline__ void pre_init(Pre& p) const {
#pragma unroll
        for (int bj = 0; bj < 2; ++bj)
#pragma unroll
            for (int n = 0; n < 2; ++n) p.cv[bj][n] = (f32x4){0.f, 0.f, 0.f, 0.f}; }
    __device__ __forceinline__ void prefetch(Pre& p, const Unit& u, int wr, int wc, int fr, int fq) const {
        const float* coef = (u.pm == 64 ? coefc : coefx) + u.pn * 256 + wc * 32 + 8 * fq;
#pragma unroll
        for (int bj = 0; bj < 2; ++bj)
#pragma unroll
            for (int n = 0; n < 2; ++n) p.cv[bj][n] = *(const f32x4*)(coef + bj * 128 + 4 * n) * scale; }
    __device__ __forceinline__ void khook(f32x4 (&)[2][2][4][2], const Unit&, int, int, int, int, int) const {}
    __device__ __forceinline__ void operator()(const f32x4 (&acc)[2][2][4][2], const Unit& u, int wr, int wc, int fr, int fq, const Pre& p) const {
        const int row0 = u.pm * 256 + wr * 64 + fr, col0 = u.pn * 256 + wc * 32 + 8 * fq;
#pragma unroll
        for (int ai = 0; ai < 2; ++ai)
#pragma unroll
            for (int m = 0; m < 4; ++m) { bf16_t* rowp = O + (size_t)(row0 + ai * 128 + m * 16) * D + col0;
#pragma unroll
                for (int bj = 0; bj < 2; ++bj) { const f32x4 v0 = acc[ai][bj][m][0] * p.cv[bj][0], v1 = acc[ai][bj][m][1] * p.cv[bj][1]; u32x4 w;
                    w.x = cvt_pk_bf16(v0[0], v0[1]); w.y = cvt_pk_bf16(v0[2], v0[3]); w.z = cvt_pk_bf16(v1[0], v1[1]); w.w = cvt_pk_bf16(v1[2], v1[3]);
                    *(u32x4*)(rowp + bj * 128) = w; } }
    }
};
struct EpiProj {
    static constexpr bool PERM = true, AFTER_DRAIN = false, KHOOK = false; static constexpr int H1 = -1, H2 = -1;
    bf16_t* P; float* DT; const float* bias;
    struct Pre { f32x4 bv[2][2]; };
    __device__ __forceinline__ void pre_init(Pre& p) const {
#pragma unroll
        for (int bj = 0; bj < 2; ++bj)
#pragma unroll
            for (int n = 0; n < 2; ++n) p.bv[bj][n] = (f32x4){0.f, 0.f, 0.f, 0.f}; }
    __device__ __forceinline__ void prefetch(Pre& p, const Unit& u, int wr, int wc, int fr, int fq) const {
        const float* b = bias + u.pn * 256 + wc * 32 + 8 * fq;
#pragma unroll
        for (int bj = 0; bj < 2; ++bj)
#pragma unroll
            for (int n = 0; n < 2; ++n) p.bv[bj][n] = *(const f32x4*)(b + bj * 128 + 4 * n); }
    __device__ __forceinline__ void khook(f32x4 (&)[2][2][4][2], const Unit&, int, int, int, int, int) const {}
    __device__ __forceinline__ void operator()(const f32x4 (&acc)[2][2][4][2], const Unit& u, int wr, int wc, int fr, int fq, const Pre& p) const {
        const int row0 = u.pm * 256 + wr * 64 + fr, col0 = u.pn * 256 + wc * 32 + 8 * fq;
        const int pn = u.pn;
        if (pn == 80) {
            if (wc < 2) {
#pragma unroll
                for (int ai = 0; ai < 2; ++ai)
#pragma unroll
                    for (int m = 0; m < 4; ++m) { float* rowp = DT + (size_t)(row0 + ai * 128 + m * 16) * 64 + wc * 32 + 8 * fq;
#pragma unroll
                        for (int n = 0; n < 2; ++n) { const f32x4 v = acc[ai][0][m][n] + p.bv[0][n]; f32x4 o;
#pragma unroll
                            for (int j = 0; j < 4; ++j) o[j] = softplus_f(v[j]);
                            *(f32x4*)(rowp + 4 * n) = o; } }
            }
            return;
        }
        const bool raw = (pn >= 8 && pn < 20) || (pn >= 28 && pn < 32), f16o = (pn >= 28 && pn < 32);
        if (raw) {
#pragma unroll
            for (int ai = 0; ai < 2; ++ai)
#pragma unroll
                for (int m = 0; m < 4; ++m) { bf16_t* rowp = P + (size_t)(row0 + ai * 128 + m * 16) * LDP + col0;
#pragma unroll
                    for (int bj = 0; bj < 2; ++bj) { const f32x4 v0 = acc[ai][bj][m][0] + p.bv[bj][0], v1 = acc[ai][bj][m][1] + p.bv[bj][1]; u32x4 w;
                        if (f16o) { w.x = pk_f16(v0[0], v0[1]); w.y = pk_f16(v0[2], v0[3]); w.z = pk_f16(v1[0], v1[1]); w.w = pk_f16(v1[2], v1[3]); }
                        else { w.x = cvt_pk_bf16(v0[0], v0[1]); w.y = cvt_pk_bf16(v0[2], v0[3]); w.z = cvt_pk_bf16(v1[0], v1[1]); w.w = cvt_pk_bf16(v1[2], v1[3]); }
                        *(u32x4*)(rowp + bj * 128) = w; } }
            return;
        }
        constexpr float NL2E = -1.4426950408889634f;
        if (pn >= 32) {
            f32x4 nb[2][2];
#pragma unroll
            for (int bj = 0; bj < 2; ++bj)
#pragma unroll
                for (int n = 0; n < 2; ++n) nb[bj][n] = p.bv[bj][n] * NL2E;
#pragma unroll
            for (int ai = 0; ai < 2; ++ai)
#pragma unroll
                for (int m = 0; m < 4; ++m) { bf16_t* rowp = P + (size_t)(row0 + ai * 128 + m * 16) * LDP + col0;
#pragma unroll
                    for (int bj = 0; bj < 2; ++bj) { f32x4 v0 = acc[ai][bj][m][0] * NL2E + nb[bj][0], v1 = acc[ai][bj][m][1] * NL2E + nb[bj][1]; u32x4 w;
#pragma unroll
                        for (int j = 0; j < 4; ++j) { v0[j] = __builtin_amdgcn_exp2f(v0[j]); v1[j] = __builtin_amdgcn_exp2f(v1[j]); }
                        v0 = v0 + 1.0f; v1 = v1 + 1.0f;
#pragma unroll
                        for (int j = 0; j < 4; ++j) { v0[j] = __builtin_amdgcn_rcpf(v0[j]); v1[j] = __builtin_amdgcn_rcpf(v1[j]); }
                        w.x = cvt_pk_bf16(v0[0], v0[1]); w.y = cvt_pk_bf16(v0[2], v0[3]); w.z = cvt_pk_bf16(v1[0], v1[1]); w.w = cvt_pk_bf16(v1[2], v1[3]);
                        *(u32x4*)(rowp + bj * 128) = w; } }
            return;
        }
        const bool isg = (pn >= 20 && pn < 28);
        const float c1 = NL2E * (isg ? 1.5957691216057308f : 1.0f), c3 = NL2E * (isg ? 0.07135481627260025f : 0.0f);
#pragma unroll
        for (int ai = 0; ai < 2; ++ai)
#pragma unroll
            for (int m = 0; m < 4; ++m) { bf16_t* rowp = P + (size_t)(row0 + ai * 128 + m * 16) * LDP + col0;
#pragma unroll
                for (int bj = 0; bj < 2; ++bj) { const f32x4 x0 = acc[ai][bj][m][0] + p.bv[bj][0], x1 = acc[ai][bj][m][1] + p.bv[bj][1]; u32x4 w;
                    f32x4 t0 = (x0 * x0 * c3 + c1) * x0, t1 = (x1 * x1 * c3 + c1) * x1;
#pragma unroll
                    for (int j = 0; j < 4; ++j) { t0[j] = __builtin_amdgcn_exp2f(t0[j]); t1[j] = __builtin_amdgcn_exp2f(t1[j]); }
                    t0 = t0 + 1.0f; t1 = t1 + 1.0f;
#pragma unroll
                    for (int j = 0; j < 4; ++j) { t0[j] = __builtin_amdgcn_rcpf(t0[j]); t1[j] = __builtin_amdgcn_rcpf(t1[j]); }
                    t0 = t0 * x0; t1 = t1 * x1;
                    w.x = cvt_pk_bf16(t0[0], t0[1]); w.y = cvt_pk_bf16(t0[2], t0[3]); w.z = cvt_pk_bf16(t1[0], t1[1]); w.w = cvt_pk_bf16(t1[2], t1[3]);
                    *(u32x4*)(rowp + bj * 128) = w; } }
    }
};
struct EpiMerge {
    static constexpr bool PERM = true, AFTER_DRAIN = false, KHOOK = KHOOK_ON; static constexpr int H1 = 32, H2 = 48;
    const bf16_t* P; bf16_t* O;
    struct Pre {};
    __device__ __forceinline__ void pre_init(Pre&) const {}
    __device__ __forceinline__ void prefetch(Pre&, const Unit&, int, int, int, int) const {}
    __device__ __forceinline__ void khook(f32x4 (&acc)[2][2][4][2], const Unit& u, int t, int wr, int wc, int fr, int fq) const {
        const int row0 = u.pm * 256 + wr * 64 + fr, col0 = u.pn * 256 + wc * 32 + 8 * fq;
        const char* nbase = (const char*)(P + PG + (t == 32 ? 0 : D)); const char* dbase = nbase + D * 2;
        unsigned off0 = ((unsigned)row0 * LDP + col0) * 2u; asm volatile("" : "+v"(off0));
#pragma unroll
        for (int ai = 0; ai < 2; ++ai) {
            u32x4 nv[4][2], dv[4][2];
#pragma unroll
            for (int m = 0; m < 4; ++m)
#pragma unroll
                for (int bj = 0; bj < 2; ++bj) { const unsigned off = off0 + (unsigned)((ai * 128 + m * 16) * LDP * 2 + bj * 256); nv[m][bj] = *(const u32x4*)(nbase + off); dv[m][bj] = *(const u32x4*)(dbase + off); }
#pragma unroll
            for (int m = 0; m < 4; ++m)
#pragma unroll
                for (int bj = 0; bj < 2; ++bj) {
                    const u32x4 a = nv[m][bj], b = dv[m][bj];
                    acc[ai][bj][m][0][0] *= bf_lo(a.x) * __builtin_amdgcn_rcpf(bf_lo(b.x)); acc[ai][bj][m][0][1] *= bf_hi(a.x) * __builtin_amdgcn_rcpf(bf_hi(b.x));
                    acc[ai][bj][m][0][2] *= bf_lo(a.y) * __builtin_amdgcn_rcpf(bf_lo(b.y)); acc[ai][bj][m][0][3] *= bf_hi(a.y) * __builtin_amdgcn_rcpf(bf_hi(b.y));
                    acc[ai][bj][m][1][0] *= bf_lo(a.z) * __builtin_amdgcn_rcpf(bf_lo(b.z)); acc[ai][bj][m][1][1] *= bf_hi(a.z) * __builtin_amdgcn_rcpf(bf_hi(b.z));
                    acc[ai][bj][m][1][2] *= bf_lo(a.w) * __builtin_amdgcn_rcpf(bf_lo(b.w)); acc[ai][bj][m][1][3] *= bf_hi(a.w) * __builtin_amdgcn_rcpf(bf_hi(b.w));
                }
            asm volatile("" ::: "memory");
        }
    }
    __device__ __forceinline__ void operator()(const f32x4 (&acc)[2][2][4][2], const Unit& u, int wr, int wc, int fr, int fq, const Pre&) const {
        const int row0 = u.pm * 256 + wr * 64 + fr, col0 = u.pn * 256 + wc * 32 + 8 * fq;
        const bf16_t* g3 = P + PG + 2 * D + col0;
#pragma unroll
        for (int ai = 0; ai < 2; ++ai)
#pragma unroll
            for (int m = 0; m < 4; ++m) { const size_t row = (size_t)(row0 + ai * 128 + m * 16);
#pragma unroll
                for (int bj = 0; bj < 2; ++bj) { const u32x4 g = *(const u32x4*)(g3 + row * LDP + bj * 128); const f32x4 v0 = acc[ai][bj][m][0], v1 = acc[ai][bj][m][1]; u32x4 w;
                    w.x = cvt_pk_bf16(v0[0] * bf_lo(g.x), v0[1] * bf_hi(g.x)); w.y = cvt_pk_bf16(v0[2] * bf_lo(g.y), v0[3] * bf_hi(g.y));
                    w.z = cvt_pk_bf16(v1[0] * bf_lo(g.z), v1[1] * bf_hi(g.z)); w.w = cvt_pk_bf16(v1[2] * bf_lo(g.w), v1[3] * bf_hi(g.w));
                    *(u32x4*)(O + row * D + col0 + bj * 128) = w; } }
    }
};

__device__ __forceinline__ int map_row(int mode, int n) {
    if (mode == 1) return ((n >> 7) << 8) + (n & 127);
    if (mode == 2) return ((n >> 7) << 8) + 128 + (n & 127);
    if (mode == 3) return n < 5120 ? n : (n < 5184 ? PDT + (n - 5120) : n - 64);
    return n;
}
__device__ __forceinline__ void transpose_item(const float* W, int N, bf16_t* WT, int Kdst, int koff, int mode, LAS float* scr, int item, int lane) {
    LAS bf16_t* T = (LAS bf16_t*)scr;
    const int nblk = N / 64, kb = item / nblk, nb_ = item - kb * nblk, k0 = 64 * kb, n0 = 64 * nb_;
    const int lk = lane >> 4, n4 = (lane & 15) * 4;
    f32x4 v[16];
#pragma unroll
    for (int i = 0; i < 16; ++i) v[i] = __builtin_nontemporal_load((const f32x4*)(W + (size_t)(k0 + 4 * i + lk) * N + n0 + n4));
#pragma unroll
    for (int i = 0; i < 16; ++i) { u32x2 w; w.x = cvt_pk_bf16(v[i][0], v[i][1]); w.y = cvt_pk_bf16(v[i][2], v[i][3]); *(LAS u32x2*)(T + (4 * i + lk) * 72 + n4) = w; }
    LDS_WAIT();
    const int r0 = map_row(mode, n0);
    const int g = lane >> 4, i16 = lane & 15, q = i16 >> 2, p = i16 & 3;
#pragma unroll
    for (int nb = 0; nb < 4; ++nb)
#pragma unroll
        for (int kh = 0; kh < 2; ++kh) { const int kc = 4 * kh + g;
            const v4s t0 = __builtin_amdgcn_ds_read_tr16_b64_v4i16((LAS v4s*)(T + (8 * kc + q) * 72 + 16 * nb + 4 * p));
            const v4s t1 = __builtin_amdgcn_ds_read_tr16_b64_v4i16((LAS v4s*)(T + (8 * kc + 4 + q) * 72 + 16 * nb + 4 * p));
            const v8s o = __builtin_shufflevector(t0, t1, 0, 1, 2, 3, 4, 5, 6, 7);
            *(v8s*)(WT + (size_t)(r0 + 16 * nb + i16) * Kdst + koff + k0 + 8 * kc) = o; }
    LDS_WAIT();
}
constexpr int I_SQ = 64 * 64, I_IN = 64 * 321, I_BS = 32 * 64, I_BM = 16 * 64, IL_ITEMS = 7 * I_SQ + I_IN + I_BS + 2 * I_BM;
constexpr int CV_PRO = (int)(0.43 * IL_ITEMS), CV_INP = (int)(0.60 * IL_ITEMS), CV_MRG = (int)(0.83 * IL_ITEMS);
__device__ __forceinline__ void convert_items(Frame& F, int l, int i0, int i1, int w, int nw) {
    LAS float* scr = (LAS float*)(F.lds + F.wave * 16384);
    bf16_t* wl = WSP(bf16_t, WS_W + (size_t)l * LW_SIZE);
    const size_t sq = (size_t)l * D * D;
    for (int it = i0 + w; it < i1; it += nw) {
        int r = it;
        if (r < I_SQ) { transpose_item(F.in[8] + sq, D, wl + LW_13A / 2, D, 0, 1, scr, r, F.lane); continue; } r -= I_SQ;
        if (r < I_SQ) { transpose_item(F.in[9] + sq, D, wl + LW_13A / 2, D, 0, 2, scr, r, F.lane); continue; } r -= I_SQ;
        if (r < I_SQ) { transpose_item(F.in[10] + sq, D, wl + LW_2A / 2, D, 0, 0, scr, r, F.lane); continue; } r -= I_SQ;
        if (r < I_IN) { transpose_item(F.in[12] + (size_t)l * D * 20544, 20544, wl + LW_IN / 2, D, 0, 3, scr, r, F.lane); continue; } r -= I_IN;
        if (r < I_BS) { transpose_item(F.in[23] + (size_t)l * 2048 * D, D, wl + LW_BR / 2, D, 0, 0, scr, r, F.lane); continue; } r -= I_BS;
        if (r < I_BM) { transpose_item(F.in[24] + (size_t)l * 1024 * D, D, wl + LW_BR / 2, D, 2048, 0, scr, r, F.lane); continue; } r -= I_BM;
        if (r < I_BM) { transpose_item(F.in[25] + (size_t)l * 1024 * D, D, wl + LW_BR / 2, D, 3072, 0, scr, r, F.lane); continue; } r -= I_BM;
        if (r < I_SQ) { transpose_item(F.in[26] + sq, D, wl + LW_OUT / 2, D, 0, 0, scr, r, F.lane); continue; } r -= I_SQ;
        if (r < I_SQ) { transpose_item(F.in[28] + sq, D, wl + LW_13B / 2, D, 0, 1, scr, r, F.lane); continue; } r -= I_SQ;
        if (r < I_SQ) { transpose_item(F.in[29] + sq, D, wl + LW_13B / 2, D, 0, 2, scr, r, F.lane); continue; } r -= I_SQ;
        transpose_item(F.in[30] + sq, D, wl + LW_2B / 2, D, 0, 0, scr, r, F.lane);
    }
}
__device__ __forceinline__ void convert_in_tail(Frame& F, int l, int i0, int i1, int rem) {
    if (l >= NL || (int)blockIdx.x < rem) return;
    convert_items(F, l, i0, i1, ((int)blockIdx.x - rem) * NWAVES + F.wave, (F.G - rem) * NWAVES);
}
__device__ __forceinline__ void prologue_a(Frame& F) {
    for (int it = F.gw; it < IL_ITEMS + (NL - 1) * CV_PRO; it += F.NGW) {
        if (it < IL_ITEMS) convert_items(F, 0, it, it + 1, 0, 1);
        else { const int r = it - IL_ITEMS, l = 1 + r / CV_PRO, i = r % CV_PRO; convert_items(F, l, i, i + 1, 0, 1); }
    }
    const int gt = blockIdx.x * NTHR + F.tid, GT = F.G * NTHR;
    for (int i = gt; i < NL * 192 * (D / 8); i += GT) { const int l = i / (192 * (D / 8)), r = i - l * (192 * (D / 8));
        *(u32x4*)(WSP(bf16_t, WS_W + (size_t)l * LW_SIZE + LW_IN) + (size_t)20544 * D + (size_t)r * 8) = (u32x4){0u, 0u, 0u, 0u}; }
    for (int i = gt; i < NL * LDP; i += GT) { const int l = i / LDP, c = i - l * LDP; float v = 0.f;
        if (c < 5120) v = F.in[13][(size_t)l * 20544 + c];
        else if (c < PDT) v = F.in[13][(size_t)l * 20544 + c + 64];
        else if (c < PDT + 64) v = F.in[13][(size_t)l * 20544 + 5120 + (c - PDT)] + F.in[17][l * 64 + (c - PDT)];
        WSP(float, WS_BIN)[i] = v; }
    for (int i = gt; i < NL * 8 * 128 * 128; i += GT) WSP(bf16_t, WS_SGW)[i] = f2bf(F.in[21][i]);
    for (int i = gt; i < 128 * 128; i += GT) { const int k = i >> 7, n = i & 127; const float a = (float)((k * n) & 127) * (1.0f / 64.0f);
        const float c = cospif(a), s = sinpif(a);
        WSP(bf16_t, WS_TAB + TAB_CW)[i] = f2h(c); WSP(bf16_t, WS_TAB + TAB_SW)[i] = f2h(s); WSP(bf16_t, WS_TAB + TAB_SWN)[i] = f2h(-s);
        const float b = (float)((k * n) & 16383) * (1.0f / 8192.0f);
        WSP(float, WS_TAB + TAB_TW)[2 * i] = cospif(b); WSP(float, WS_TAB + TAB_TW)[2 * i + 1] = sinpif(b); }
    for (int i = gt; i < 128; i += GT) { const float b = (float)i * (1.0f / 128.0f); WSP(float, WS_TAB + TAB_TWC)[2 * i] = cospif(b); WSP(float, WS_TAB + TAB_TWC)[2 * i + 1] = sinpif(b); }
    for (int b = blockIdx.x; b < 2 * NL * 32; b += F.G) {
        const int l = b >> 6, v = (b >> 5) & 1, r = (b & 31) * 8 + F.wave; const float* cv = v ? F.in[3] : F.in[1];
        const float* w1 = F.in[4] + (size_t)l * D * 256 + r; float s_ = 0.f;
#pragma unroll 8
        for (int d = F.lane; d < D; d += 64) s_ += silu_f(cv[d]) * w1[(size_t)d * 256];
        s_ = wave_sum(s_);
        if (F.lane == 0) WSP(float, WS_T1)[(l * 2 + v) * 256 + r] = s_;
    }
}
__device__ __forceinline__ void prologue_b(Frame& F) {
    const int gt = blockIdx.x * NTHR + F.tid, GT = F.G * NTHR;
    for (int i = gt; i < NL * 9 * D; i += GT) { const int l = i / (9 * D), n = i - l * (9 * D);
        const float* w2 = F.in[5] + (size_t)l * 256 * 9 * D + n; const float* t0 = WSP(float, WS_T1) + (l * 2) * 256; const float* t1 = t0 + 256;
        float s0 = 0.f, s1 = 0.f;
#pragma unroll 8
        for (int r = 0; r < 256; ++r) { const float w = w2[(size_t)r * 9 * D]; s0 += t0[r] * w; s1 += t1[r] * w; }
        const float b = F.in[6][(size_t)l * 9 * D + n];
        WSP(float, WS_MOD)[(size_t)(l * 2 + 0) * 9 * D + n] = s0 + b; WSP(float, WS_MOD)[(size_t)(l * 2 + 1) * 9 * D + n] = s1 + b; }
}
__device__ __forceinline__ const float* modv(Frame& F, int l, int v, int j) { return WSP(float, WS_MOD) + ((size_t)(l * 2 + v) * 9 + j) * D; }

struct NormRow { f32x4 x[16]; u32x2 d[16]; };
__device__ __forceinline__ void norm_load(NormRow& R, const float* src, const bf16_t* dl, int lane) {
#pragma unroll
    for (int j = 0; j < 16; ++j) R.x[j] = *(const f32x4*)(src + lane * 4 + 256 * j);
    if (dl) {
#pragma unroll
        for (int j = 0; j < 16; ++j) R.d[j] = *(const u32x2*)(dl + lane * 4 + 256 * j); }
}
__device__ __forceinline__ void norm_rows(Frame& F, const float* xin, const float* cin, float* xout, float* cout, const bf16_t* DL, int row0, int rstride, int rend, const bf16_t* DL2 = nullptr) {
    LAS float* GM = (LAS float*)F.lds; LAS float* SH = GM + 2 * D;
    bf16_t* H = WSP(bf16_t, WS_H);
    NormRow R, Rn;
    int row = row0;
    if (row < rend) { const int v = row >= NX; const size_t ro = v ? (size_t)(row - NX) * D : (size_t)row * D; norm_load(R, (v ? cin : xin) + ro, DL ? DL + (size_t)row * D : DL, F.lane); }
    for (; row < rend; row += rstride) {
        const int rn = row + rstride;
        if (rn < rend) { const int vn = rn >= NX; const size_t rno = vn ? (size_t)(rn - NX) * D : (size_t)rn * D; norm_load(Rn, (vn ? cin : xin) + rno, DL ? DL + (size_t)rn * D : DL, F.lane); }
        const int v = row >= NX; const size_t ro = v ? (size_t)(row - NX) * D : (size_t)row * D;
        float ss = 0.f;
        if (DL) { float* dst = (v ? cout : xout) + ro;
            if (DL2 && v) {
#pragma unroll
                for (int j = 0; j < 16; ++j) { const u32x2 d = *(const u32x2*)(DL2 + (size_t)row * D + F.lane * 4 + 256 * j); R.x[j] = R.x[j] + (f32x4){bf_lo(d.x), bf_hi(d.x), bf_lo(d.y), bf_hi(d.y)}; } }
#pragma unroll
            for (int j = 0; j < 16; ++j) { const u32x2 d = R.d[j];
                R.x[j] = R.x[j] + (f32x4){bf_lo(d.x), bf_hi(d.x), bf_lo(d.y), bf_hi(d.y)}; *(f32x4*)(dst + F.lane * 4 + 256 * j) = R.x[j]; } }
#pragma unroll
        for (int j = 0; j < 16; ++j) ss += (R.x[j][0] * R.x[j][0] + R.x[j][1] * R.x[j][1]) + (R.x[j][2] * R.x[j][2] + R.x[j][3] * R.x[j][3]);
        const float rinv = 1.0f / sqrtf(wave_sum(ss) * (1.0f / D) + EPS);
#pragma unroll
        for (int j = 0; j < 16; ++j) { const int c = F.lane * 4 + 256 * j; const f32x4 gm = *(const LAS f32x4*)(GM + v * D + c), sh = *(const LAS f32x4*)(SH + v * D + c);
            const f32x4 o = R.x[j] * rinv * gm + sh; u32x2 w; w.x = cvt_pk_bf16(o[0], o[1]); w.y = cvt_pk_bf16(o[2], o[3]);
            *(u32x2*)(H + (size_t)row * D + c) = w; }
        if (rn < rend) {
#pragma unroll
            for (int j = 0; j < 16; ++j) { R.x[j] = Rn.x[j]; R.d[j] = Rn.d[j]; } }
    }
}
struct CtxOrder {
    int c;
    __device__ bool next(int i, pg8::Unit& u) const { if (i != 0) return false; u.pm = 64; u.pn = c; return true; }
    __device__ __forceinline__ void a_ready(const pg8::Unit&) const {}
    __device__ __forceinline__ void done(const pg8::Unit&) const {}
};
struct CtxWork { bool on; const bf16_t* A; const bf16_t* Bt; const float* coefc; float scale; unsigned* cnt; };
__device__ __forceinline__ void norm_phase(Frame& F, const float* xin, const float* cin, float* xout, float* cout, const bf16_t* DL, const float* g, int l, int jsh, int nrows, const CtxWork cw) {
    const bool team = cw.on && blockIdx.x < 32;
    if (team) {
        const int kh = (int)blockIdx.x >> 4;
        pg8::Gemm gg{cw.A + kh * 2048, cw.Bt + kh * 2048, NT, D, 2048, D}; CtxOrder S{(int)blockIdx.x & 15}; EpiDelta E{kh ? WSP(bf16_t, WS_DL2) : WSP(bf16_t, WS_DL), cw.coefc, cw.coefc, cw.scale};
        pg8::gemm_phase<EpiDelta, CtxOrder, true, true>(F.lds, gg, S, E);
        __builtin_amdgcn_fence(__ATOMIC_RELEASE, "agent"); asm volatile("s_waitcnt vmcnt(0)" ::: "memory");
        __syncthreads();
        if (F.tid == 0) (void)__hip_atomic_fetch_add(cw.cnt, 1u, __ATOMIC_RELAXED, __HIP_MEMORY_SCOPE_AGENT);
    }
    LAS float* GM = (LAS float*)F.lds;
    LAS float* SH = GM + 2 * D;
    __syncthreads();
    for (int i = F.tid; i < 2 * D; i += NTHR) { const int v = i >> 12, c = i & (D - 1); GM[i] = g[c] * (1.0f + modv(F, l, v, jsh + 1)[c]); SH[i] = modv(F, l, v, jsh)[c]; }
    __syncthreads();
    if (!cw.on) norm_rows(F, xin, cin, xout, cout, DL, F.gw, F.NGW, nrows);
    else if (!team) norm_rows(F, xin, cin, xout, cout, DL, ((int)blockIdx.x - 32) * NWAVES + F.wave, (F.G - 32) * NWAVES, NX - 32 * NWAVES);
    else {
        if (F.tid == 0) { unsigned sp = 0; while (__hip_atomic_load(cw.cnt, __ATOMIC_RELAXED, __HIP_MEMORY_SCOPE_AGENT) < 32u) { __builtin_amdgcn_s_sleep(2); if (++sp > (1u << 22)) break; }
            __builtin_amdgcn_fence(__ATOMIC_ACQUIRE, "agent"); asm volatile("s_waitcnt vmcnt(0)" ::: "memory"); }
        __syncthreads();
        norm_rows(F, xin, cin, xout, cout, DL, NX - 32 * NWAVES + (int)blockIdx.x * NWAVES + F.wave, 32 * NWAVES, NT, WSP(bf16_t, WS_DL2));
    }
    __syncthreads();
}
__device__ __forceinline__ void final_norm_phase(Frame& F, const bf16_t* DL, const float* g) {
    for (int row = F.gw; row < NX; row += F.NGW) {
        float* src = F.out + (size_t)row * D;
        f32x4 x[16]; float ss = 0.f;
#pragma unroll
        for (int j = 0; j < 16; ++j) { const u32x2 d = *(const u32x2*)(DL + (size_t)row * D + F.lane * 4 + 256 * j);
            x[j] = *(const f32x4*)(src + F.lane * 4 + 256 * j) + (f32x4){bf_lo(d.x), bf_hi(d.x), bf_lo(d.y), bf_hi(d.y)};
            ss += (x[j][0] * x[j][0] + x[j][1] * x[j][1]) + (x[j][2] * x[j][2] + x[j][3] * x[j][3]); }
        const float rinv = 1.0f / sqrtf(wave_sum(ss) * (1.0f / D) + EPS);
#pragma unroll
        for (int j = 0; j < 16; ++j) { const int c = F.lane * 4 + 256 * j; *(f32x4*)(src + c) = x[j] * rinv * *(const f32x4*)(g + c); }
    }
}

struct ConvRegs { u32x4 v[5][2]; };
__device__ __forceinline__ void conv_load(Frame& F, ConvRegs& R, int ci, int cb) {
    const bf16_t* P = WSP(bf16_t, WS_P);
    const int t0 = chunk_t0(ci), q = F.tid >> 2, cq = F.tid & 3, ch0 = cb * 64 + cq * 16, tq = t0 + q;
    const int seg_lo = ci < 2 ? NX : (tq & ~63), seg_hi = ci < 2 ? NT : seg_lo + 64;
#pragma unroll
    for (int k = 0; k < 5; ++k) { const int ts = tq + k - 2; const bool ok = ts >= seg_lo && ts < seg_hi; const int tc = ok ? ts : tq;
        const u32x4 a = *(const u32x4*)(P + (size_t)tc * LDP + PXBC + ch0), b = *(const u32x4*)(P + (size_t)tc * LDP + PXBC + ch0 + 8);
        R.v[k][0] = ok ? a : (u32x4){0u, 0u, 0u, 0u}; R.v[k][1] = ok ? b : (u32x4){0u, 0u, 0u, 0u}; }
}
__device__ __forceinline__ void conv_compute(Frame& F, const ConvRegs& R, int l, int ci, int cb) {
    bf16_t* XC = WSP(bf16_t, WS_XC); bf16_t* XT = WSP(bf16_t, WS_XT);
    LAS bf16_t* T = (LAS bf16_t*)F.lds; constexpr int TS = 136;
    const int t0 = chunk_t0(ci), q = F.tid >> 2, cq = F.tid & 3, ch0 = cb * 64 + cq * 16, tq = t0 + q;
    const LAS float* cw = (const LAS float*)(F.lds + 32768) + ch0; const LAS float* cbv = cw + 5 * 3072;
    float a[16];
#pragma unroll
    for (int j = 0; j < 4; ++j) { const f32x4 b = *(const LAS f32x4*)(cbv + 4 * j); a[4 * j] = b[0]; a[4 * j + 1] = b[1]; a[4 * j + 2] = b[2]; a[4 * j + 3] = b[3]; }
#pragma unroll
    for (int k = 0; k < 5; ++k) { const u32x4 v0 = R.v[k][0], v1 = R.v[k][1];
        const float x[16] = {bf_lo(v0.x), bf_hi(v0.x), bf_lo(v0.y), bf_hi(v0.y), bf_lo(v0.z), bf_hi(v0.z), bf_lo(v0.w), bf_hi(v0.w), bf_lo(v1.x), bf_hi(v1.x), bf_lo(v1.y), bf_hi(v1.y), bf_lo(v1.z), bf_hi(v1.z), bf_lo(v1.w), bf_hi(v1.w)};
#pragma unroll
        for (int j = 0; j < 4; ++j) { const f32x4 w = *(const LAS f32x4*)(cw + k * 3072 + 4 * j); a[4 * j] += w[0] * x[4 * j]; a[4 * j + 1] += w[1] * x[4 * j + 1]; a[4 * j + 2] += w[2] * x[4 * j + 2]; a[4 * j + 3] += w[3] * x[4 * j + 3]; } }
#pragma unroll
    for (int j = 0; j < 16; ++j) a[j] = silu_f(a[j]);
    u32x4 o0, o1; o0.x = cvt_pk_bf16(a[0], a[1]); o0.y = cvt_pk_bf16(a[2], a[3]); o0.z = cvt_pk_bf16(a[4], a[5]); o0.w = cvt_pk_bf16(a[6], a[7]);
    o1.x = cvt_pk_bf16(a[8], a[9]); o1.y = cvt_pk_bf16(a[10], a[11]); o1.z = cvt_pk_bf16(a[12], a[13]); o1.w = cvt_pk_bf16(a[14], a[15]);
    *(u32x4*)(XC + (size_t)tq * 3072 + ch0) = o0; *(u32x4*)(XC + (size_t)tq * 3072 + ch0 + 8) = o1;
    if (cb < 40) {
        const unsigned w[8] = {o0.x, o0.y, o0.z, o0.w, o1.x, o1.y, o1.z, o1.w};
#pragma unroll
        for (int j = 0; j < 8; ++j) { T[(cq * 16 + 2 * j) * TS + q] = (bf16_t)(w[j] & 0xffffu); T[(cq * 16 + 2 * j + 1) * TS + q] = (bf16_t)(w[j] >> 16); }
        LDS_BAR();
        const int r = F.tid >> 3, part = F.tid & 7;
        const u32x4 t0v = *(const LAS u32x4*)(T + r * TS + part * 16), t1v = *(const LAS u32x4*)(T + r * TS + part * 16 + 8);
        bf16_t* dst = XT + (size_t)(cb * 64 + r) * NT + t0 + part * 16;
        *(u32x4*)dst = t0v; *(u32x4*)(dst + 8) = t1v;
        LDS_BAR();
    }
}
__device__ __forceinline__ void conv_all(Frame& F, int l) {
    constexpr int NU = NCHK * 48;
    { LAS float* wl_ = (LAS float*)(F.lds + 32768);
      __syncthreads();
      for (int i = F.tid; i < 5 * 3072 / 4; i += NTHR) *(LAS f32x4*)(wl_ + 4 * i) = *(const f32x4*)(F.in[14] + (size_t)l * 5 * 3072 + 4 * i);
      for (int i = F.tid; i < 3072 / 4; i += NTHR) *(LAS f32x4*)(wl_ + 5 * 3072 + 4 * i) = *(const f32x4*)(F.in[15] + (size_t)l * 3072 + 4 * i);
      __syncthreads(); }
    ConvRegs R0, R1;
    int u = blockIdx.x;
    if (u < NU) conv_load(F, R0, u / 48, u % 48);
    for (; u < NU; u += 2 * F.G) {
        const int u1 = u + F.G, u2 = u + 2 * F.G;
        { const int v1 = u1 < NU ? u1 : u; conv_load(F, R1, v1 / 48, v1 % 48); }
        conv_compute(F, R0, l, u / 48, u % 48);
        { const int v2 = u2 < NU ? u2 : u; conv_load(F, R0, v2 / 48, v2 % 48); }
        if (u1 < NU) conv_compute(F, R1, l, u1 / 48, u1 % 48);
    }
}
__device__ __forceinline__ void cumsum_job(Frame& F, int l, int job) {
    const int ci = job >> 3, d = (job >> 2) & 1, hg = job & 3, t0 = chunk_t0(ci), lane = F.lane, hd = hg * 8 + (lane & 7), sg = lane >> 3;
    const float* DT = WSP(float, WS_DT) + (size_t)(t0 + 16 * sg) * 64 + d * 32 + hd;
    const float Aneg = -expf(F.in[16][l * 64 + d * 32 + hd]);
    float dtv[16]; float part = 0.f;
#pragma unroll
    for (int k = 0; k < 16; ++k) { dtv[k] = DT[(size_t)k * 64]; part += dtv[k] * Aneg; }
    float incl = part;
#pragma unroll
    for (int o = 8; o < 64; o <<= 1) { const float t = __shfl_up(incl, o); if (lane >= o) incl += t; }
    const float total = __shfl(incl, 56 + (lane & 7));
    float run = incl - part;
    const size_t o0 = ((size_t)d * NT + t0 + 16 * sg) * 32 + hd;
    float* CSp = WSP(float, WS_CS) + o0; float* EIp = WSP(float, WS_EIN) + o0; float* WEp = WSP(float, WS_WEND) + o0;
#pragma unroll
    for (int k = 0; k < 16; ++k) { const float dt = dtv[k], a = dt * Aneg;
        const float c = d == 0 ? run + a : total - run;
        run += a;
        CSp[(size_t)k * 32] = c; EIp[(size_t)k * 32] = __expf(c); WEp[(size_t)k * 32] = __expf(total - c) * dt; }
    if (sg == 0) WSP(float, WS_TOT)[(d * NCHK + ci) * 32 + hd] = total;
}
__device__ __forceinline__ void vrms_job4(Frame& F, int tb) {
    u32x4 a[4], b[4]; float ss[4];
#pragma unroll
    for (int r = 0; r < 4; ++r) { const int t = tb + r < NT ? tb + r : NT - 1; const bf16_t* p = WSP(bf16_t, WS_P) + (size_t)t * LDP + PV + F.lane * 16; a[r] = *(const u32x4*)p; b[r] = *(const u32x4*)(p + 8); }
#pragma unroll
    for (int r = 0; r < 4; ++r) { const unsigned w[8] = {a[r].x, a[r].y, a[r].z, a[r].w, b[r].x, b[r].y, b[r].z, b[r].w}; float s_ = 0.f;
#pragma unroll
        for (int j = 0; j < 8; ++j) { const float lo = bf_lo(w[j]), hi = bf_hi(w[j]); s_ += lo * lo + hi * hi; }
        ss[r] = s_; }
#pragma unroll
    for (int o = 1; o < 64; o <<= 1) {
#pragma unroll
        for (int r = 0; r < 4; ++r) ss[r] += __shfl_xor(ss[r], o); }
    if (F.lane < 4 && tb + F.lane < NT) { const float v = F.lane == 0 ? ss[0] : F.lane == 1 ? ss[1] : F.lane == 2 ? ss[2] : ss[3]; WSP(float, WS_RINV)[tb + F.lane] = 1.0f / sqrtf(v * (1.0f / 1024.0f) + EPS); }
}
__device__ __forceinline__ void fft_tables_to_lds(Frame& F, const bf16_t* t0, const bf16_t* t1) {
    LAS bf16_t* L0 = (LAS bf16_t*)(F.lds + 65536); LAS bf16_t* L1 = L0 + 128 * 136;
    __syncthreads();
    for (int i = F.tid; i < 2048; i += NTHR) { const int r = i >> 4, c = (i & 15) * 8; *(LAS u32x4*)(L0 + r * 136 + c) = *(const u32x4*)(t0 + r * 128 + c); *(LAS u32x4*)(L1 + r * 136 + c) = *(const u32x4*)(t1 + r * 128 + c); }
    __syncthreads();
}
__device__ __forceinline__ void fft1_unit(Frame& F, int lb2, int g, int mb) {
    const bf16_t* P = WSP(bf16_t, WS_P);
    bf16_t* GR = WSP(bf16_t, WS_GPR); bf16_t* GI = WSP(bf16_t, WS_GPI);
    LAS bf16_t* LR = (LAS bf16_t*)F.lds;
    LAS bf16_t* LI = LR + 128 * 16 * 8;
    const LAS bf16_t* CWl = (const LAS bf16_t*)(F.lds + 65536); const LAS bf16_t* SWl = CWl + 128 * 136;
    const int w = F.wave, l15 = F.lane & 15, h = F.lane >> 4, l2 = 8 * lb2 + w;
    f32x4 zr[8], zi[8];
    v8s bc[4], bs[4];
    v8s af[8][4];
    const bf16_t* rowb = P + (size_t)(128 * l15 + l2) * LDP + PF + g * 128 + 8 * h;
#pragma unroll
    for (int lb = 0; lb < 4; ++lb)
#pragma unroll
        for (int ks = 0; ks < 4; ++ks) af[lb][ks] = ld16(rowb + (size_t)(2048 * lb) * LDP + 32 * ks);
#pragma unroll
    for (int ks = 0; ks < 4; ++ks) { bc[ks] = *(const LAS v8s*)(CWl + (16 * mb + l15) * 136 + 32 * ks + 8 * h); bs[ks] = *(const LAS v8s*)(SWl + (16 * mb + l15) * 136 + 32 * ks + 8 * h); }
    asm volatile("" ::: "memory");
#pragma unroll
    for (int lb = 4; lb < 8; ++lb)
#pragma unroll
        for (int ks = 0; ks < 4; ++ks) af[lb][ks] = ld16(rowb + (size_t)(2048 * lb) * LDP + 32 * ks);
    asm volatile("" ::: "memory");
#pragma unroll
    for (int lb = 0; lb < 8; ++lb) { zr[lb] = (f32x4){0.f, 0.f, 0.f, 0.f}; zi[lb] = zr[lb];
#pragma unroll
        for (int ks = 0; ks < 4; ++ks) { zr[lb] = mma_h(af[lb][ks], bc[ks], zr[lb]); zi[lb] = mma_h(af[lb][ks], bs[ks], zi[lb]); } }
    v8s br[4], bi[4], bn[4];
#pragma unroll
    for (int ks = 0; ks < 4; ++ks) { const f32x4 a = zr[2 * ks], b = zr[2 * ks + 1], c = zi[2 * ks], d = zi[2 * ks + 1];
        br[ks] = pack8_h(a[0], a[1], a[2], a[3], b[0], b[1], b[2], b[3]); bi[ks] = pack8_h(c[0], c[1], c[2], c[3], d[0], d[1], d[2], d[3]);
        bn[ks] = pack8_h(-c[0], -c[1], -c[2], -c[3], -d[0], -d[1], -d[2], -d[3]); }
    __syncthreads();
#pragma unroll 2
    for (int kb = 0; kb < 8; ++kb) {
        f32x4 gr = {0.f, 0.f, 0.f, 0.f}, gi = gr;
        const LAS bf16_t* cr = CWl + (16 * kb + l15) * 136 + 4 * h; const LAS bf16_t* sr = SWl + (16 * kb + l15) * 136 + 4 * h;
#pragma unroll
        for (int ks = 0; ks < 4; ++ks) {
            const v4s c0 = *(const LAS v4s*)(cr + 32 * ks), c1 = *(const LAS v4s*)(cr + 32 * ks + 16), s0 = *(const LAS v4s*)(sr + 32 * ks), s1 = *(const LAS v4s*)(sr + 32 * ks + 16);
            const v8s ac = __builtin_shufflevector(c0, c1, 0, 1, 2, 3, 4, 5, 6, 7), as = __builtin_shufflevector(s0, s1, 0, 1, 2, 3, 4, 5, 6, 7);
            gr = mma_h(ac, br[ks], gr); gr = mma_h(as, bn[ks], gr); gi = mma_h(ac, bi[ks], gi); gi = mma_h(as, br[ks], gi); }
#pragma unroll
        for (int r = 0; r < 4; ++r) { const int k1 = 16 * kb + 4 * h + r; const float ang = (float)((k1 * l2) & 16383) * (1.0f / 16384.0f);
            const float ct = __builtin_amdgcn_cosf(ang), st = __builtin_amdgcn_sinf(ang);
            const float pr = gr[r] * ct - gi[r] * st, pi = gr[r] * st + gi[r] * ct;
            LR[(k1 * 16 + l15) * 8 + w] = f2h(pr); LI[(k1 * 16 + l15) * 8 + w] = f2h(pi); }
    }
    __syncthreads();
#pragma unroll
    for (int j = 0; j < 4; ++j) { const int p = F.tid + NTHR * j, k1 = p >> 4, c = p & 15;
        const size_t o = ((size_t)k1 * 1024 + g * 128 + 16 * mb + c) * 128 + 8 * lb2;
        *(u32x4*)(GR + o) = *(const LAS u32x4*)(LR + p * 8); *(u32x4*)(GI + o) = *(const LAS u32x4*)(LI + p * 8); }
}
__device__ __forceinline__ void fft1c_unit(Frame& F, int g) {
    const bf16_t* P = WSP(bf16_t, WS_P); const bf16_t* CW = WSP(bf16_t, WS_TAB + TAB_CW); const bf16_t* SW = WSP(bf16_t, WS_TAB + TAB_SW);
    const float* TWC = WSP(float, WS_TAB + TAB_TWC);
    bf16_t* GR = WSP(bf16_t, WS_GPC); bf16_t* GI = WSP(bf16_t, WS_GPC + MiB);
    const int w = F.wave, l15 = F.lane & 15, h = F.lane >> 4;
    v8s bc[4], bs[4];
#pragma unroll
    for (int ks = 0; ks < 4; ++ks) { bc[ks] = ld16(CW + (16 * w + l15) * 128 + 32 * ks + 8 * h); bs[ks] = ld16(SW + (16 * w + l15) * 128 + 32 * ks + 8 * h); }
    const int ch = g * 128 + 16 * w + l15;
#pragma unroll 1
    for (int lb = 0; lb < 8; ++lb) {
        f32x4 ar = {0.f, 0.f, 0.f, 0.f}, ai = ar, br = ar, bi = ar;
        const bf16_t* ra = P + (size_t)(NX + 16 * lb + l15) * LDP + PF + g * 128 + 8 * h; const bf16_t* rb = ra + (size_t)128 * LDP;
#pragma unroll
        for (int ks = 0; ks < 4; ++ks) { const v8s a = ld16(ra + 32 * ks), b = ld16(rb + 32 * ks);
            ar = mma_h(a, bc[ks], ar); ai = mma_h(a, bs[ks], ai); br = mma_h(b, bc[ks], br); bi = mma_h(b, bs[ks], bi); }
        unsigned short o0r[4], o0i[4], o1r[4], o1i[4];
#pragma unroll
        for (int r = 0; r < 4; ++r) { const int l2 = 16 * lb + 4 * h + r; const f32x2 tw = *(const f32x2*)(TWC + 2 * l2);
            const float sr = ar[r] + br[r], si = ai[r] + bi[r], dr = ar[r] - br[r], di = ai[r] - bi[r];
            o0r[r] = f2h(sr); o0i[r] = f2h(si); o1r[r] = f2h(dr * tw.x - di * tw.y); o1i[r] = f2h(dr * tw.y + di * tw.x); }
        const size_t o0 = ((size_t)0 * 1024 + ch) * 128 + 16 * lb + 4 * h, o1 = ((size_t)1 * 1024 + ch) * 128 + 16 * lb + 4 * h;
        *(u32x2*)(GR + o0) = (u32x2){(unsigned)o0r[0] | ((unsigned)o0r[1] << 16), (unsigned)o0r[2] | ((unsigned)o0r[3] << 16)};
        *(u32x2*)(GI + o0) = (u32x2){(unsigned)o0i[0] | ((unsigned)o0i[1] << 16), (unsigned)o0i[2] | ((unsigned)o0i[3] << 16)};
        *(u32x2*)(GR + o1) = (u32x2){(unsigned)o1r[0] | ((unsigned)o1r[1] << 16), (unsigned)o1r[2] | ((unsigned)o1r[3] << 16)};
        *(u32x2*)(GI + o1) = (u32x2){(unsigned)o1i[0] | ((unsigned)o1i[1] << 16), (unsigned)o1i[2] | ((unsigned)o1i[3] << 16)};
    }
}
__device__ __forceinline__ void fft2_unit(Frame& F, const bf16_t* GR, const bf16_t* GI, int k1, int g, int rowbase, int KS, float scale) {
    const LAS bf16_t* CWl = (const LAS bf16_t*)(F.lds + 65536); const LAS bf16_t* SNl = CWl + 128 * 136;
    bf16_t* Y = WSP(bf16_t, WS_Y);
    const int w = F.wave, l15 = F.lane & 15, h = F.lane >> 4;
    v8s ar[4], ai[4];
    const size_t ab = ((size_t)k1 * 1024 + g * 128 + 16 * w + l15) * 128 + 8 * h;
#pragma unroll
    for (int ks = 0; ks < 4; ++ks) { ar[ks] = ld16(GR + ab + 32 * ks); ai[ks] = ld16(GI + ab + 32 * ks); }
#pragma unroll 2
    for (int kb = 0; kb < 8; ++kb) {
        f32x4 acc = {0.f, 0.f, 0.f, 0.f};
        const LAS bf16_t* cr = CWl + (16 * kb + l15) * 136 + 8 * h; const LAS bf16_t* sr = SNl + (16 * kb + l15) * 136 + 8 * h;
#pragma unroll
        for (int ks = 0; ks < 4; ++ks) { acc = mma_h(ar[ks], *(const LAS v8s*)(cr + 32 * ks), acc); acc = mma_h(ai[ks], *(const LAS v8s*)(sr + 32 * ks), acc); }
        const int row = rowbase + k1 + KS * (16 * kb + l15);
        u32x2 o; o.x = cvt_pk_bf16(acc[0] * scale, acc[1] * scale); o.y = cvt_pk_bf16(acc[2] * scale, acc[3] * scale);
        *(u32x2*)(Y + (size_t)row * D + 3072 + g * 128 + 16 * w + 4 * h) = o;
    }
}

struct LocPF { u32x4 x[2]; float w; };
__device__ __forceinline__ void loc_pf_x(Frame& F, LocPF& P, int t0, int hd) {
    const bf16_t* XT = WSP(bf16_t, WS_XT);
#pragma unroll
    for (int j = 0; j < 2; ++j) { const int id = F.tid + NTHR * j, row = id >> 4, c = (id & 15) * 8; P.x[j] = *(const u32x4*)(XT + (size_t)(hd * 64 + row) * NT + t0 + c); }
    { const int t = F.tid & 255, dd = t >> 7, s_ = t & 127; P.w = WSP(float, WS_WEND)[((size_t)dd * NT + t0 + s_) * 32 + hd]; }
}
__device__ __forceinline__ void loc_commit_x(Frame& F, const LocPF& P, LAS bf16_t* XAl, LAS float* wl) {
#pragma unroll
    for (int j = 0; j < 2; ++j) { const int id = F.tid + NTHR * j, row = id >> 4, c = (id & 15) * 8; *(LAS u32x4*)(XAl + row * 136 + c) = P.x[j]; }
    if (F.tid < 256) wl[F.tid] = P.w;
}
__device__ __forceinline__ void ssd_local_unit4(Frame& F, int ci, int hd0) {
    const bf16_t* XT = WSP(bf16_t, WS_XT); bf16_t* LS = WSP(bf16_t, WS_LS);
    LAS bf16_t* BTl = (LAS bf16_t*)F.lds;
    LAS bf16_t* XAl = BTl + 128 * 136;
    LAS float* wl = (LAS float*)(XAl + 64 * 136);
    const int t0 = chunk_t0(ci), g = hd0 >> 3, w = F.wave, l15 = F.lane & 15, h = F.lane >> 4, d = w >> 2, nq = w & 3;
    u32x4 pb_[4]; LocPF P;
#pragma unroll
    for (int j = 0; j < 4; ++j) { const int id = F.tid + NTHR * j, row = id >> 4, c = (id & 15) * 8; pb_[j] = *(const u32x4*)(XT + (size_t)(2048 + g * 128 + row) * NT + t0 + c); }
    loc_pf_x(F, P, t0, hd0);
    LDS_BAR();
#pragma unroll
    for (int j = 0; j < 4; ++j) { const int id = F.tid + NTHR * j, row = id >> 4, c = (id & 15) * 8; *(LAS u32x4*)(BTl + row * 136 + c) = pb_[j]; }
    loc_commit_x(F, P, XAl, wl);
    loc_pf_x(F, P, t0, hd0 + 1);
    LDS_BAR();
    v8s bfr[4][2];
#pragma unroll
    for (int ks = 0; ks < 4; ++ks)
#pragma unroll
        for (int nb = 0; nb < 2; ++nb) bfr[ks][nb] = *(const LAS v8s*)(BTl + (nq * 32 + 16 * nb + l15) * 136 + 32 * ks + 8 * h);
#pragma unroll
    for (int j = 0; j < 4; ++j) {
        const int hd = hd0 + j;
        if (j > 0) LDS_BAR();
        f32x4 acc[4][2];
#pragma unroll
        for (int pb = 0; pb < 4; ++pb) { acc[pb][0] = (f32x4){0.f, 0.f, 0.f, 0.f}; acc[pb][1] = acc[pb][0]; }
#pragma unroll
        for (int ks = 0; ks < 4; ++ks) {
            const f32x4 w0 = *(const LAS f32x4*)(wl + d * 128 + 32 * ks + 8 * h), w1 = *(const LAS f32x4*)(wl + d * 128 + 32 * ks + 8 * h + 4);
#pragma unroll
            for (int pb = 0; pb < 4; ++pb) {
                const u32x4 raw = *(const LAS u32x4*)(XAl + (16 * pb + l15) * 136 + 32 * ks + 8 * h);
                const v8s a = pack8_bf(bf_lo(raw.x) * w0[0], bf_hi(raw.x) * w0[1], bf_lo(raw.y) * w0[2], bf_hi(raw.y) * w0[3], bf_lo(raw.z) * w1[0], bf_hi(raw.z) * w1[1], bf_lo(raw.w) * w1[2], bf_hi(raw.w) * w1[3]);
                acc[pb][0] = mma_bf(bfr[ks][0], a, acc[pb][0]); acc[pb][1] = mma_bf(bfr[ks][1], a, acc[pb][1]);
            }
        }
        if (j < 3) { LDS_BAR(); loc_commit_x(F, P, XAl, wl); if (j < 2) loc_pf_x(F, P, t0, hd + 2); }
        bf16_t* dst = LS + ((size_t)(d * NCHK + ci) * 32 + hd) * 8192;
#pragma unroll
        for (int pb = 0; pb < 4; ++pb)
#pragma unroll
            for (int nb = 0; nb < 2; ++nb) { u32x2 o; o.x = cvt_pk_bf16(acc[pb][nb][0], acc[pb][nb][1]); o.y = cvt_pk_bf16(acc[pb][nb][2], acc[pb][nb][3]);
                *(u32x2*)(dst + (16 * pb + l15) * 128 + nq * 32 + 16 * nb + 4 * h) = o; }
        if (ci < 2) {
            bf16_t* sec = WSP(bf16_t, WS_SEC) + ((size_t)(d * 2 + (1 - ci)) * 32 + hd) * 8192; const bool keep = (d == ci);
#pragma unroll
            for (int pb = 0; pb < 4; ++pb)
#pragma unroll
                for (int nb = 0; nb < 2; ++nb)
                    { u32x2 o; o.x = keep ? cvt_pk_bf16(acc[pb][nb][0], acc[pb][nb][1]) : 0u; o.y = keep ? cvt_pk_bf16(acc[pb][nb][2], acc[pb][nb][3]) : 0u; *(u32x2*)(sec + (16 * pb + l15) * 128 + nq * 32 + 16 * nb + 4 * h) = o; }
        }
    }
}
__device__ __forceinline__ void sgu_unit(Frame& F, int l, int ci, int g) {
    const bf16_t* P = WSP(bf16_t, WS_P); bf16_t* Y = WSP(bf16_t, WS_Y);
    LAS bf16_t* VT = (LAS bf16_t*)F.lds; constexpr int VS = 136;
    const int t0 = chunk_t0(ci), w = F.wave, lane = F.lane, l15 = lane & 15, h = lane >> 4;
    __syncthreads();
    { const int row = F.tid >> 2, c0 = (F.tid & 3) * 32; const float ri = WSP(float, WS_RINV)[t0 + row];
      const float* gn = F.in[20] + (size_t)l * 1024 + g * 128 + c0;
#pragma unroll
      for (int j = 0; j < 4; ++j) { const u32x4 v = *(const u32x4*)(P + (size_t)(t0 + row) * LDP + PV + g * 128 + c0 + 8 * j);
          const f32x4 g0 = *(const f32x4*)(gn + 8 * j), g1 = *(const f32x4*)(gn + 8 * j + 4); u32x4 o;
          o.x = cvt_pk_bf16(bf_lo(v.x) * ri * g0[0], bf_hi(v.x) * ri * g0[1]); o.y = cvt_pk_bf16(bf_lo(v.y) * ri * g0[2], bf_hi(v.y) * ri * g0[3]);
          o.z = cvt_pk_bf16(bf_lo(v.z) * ri * g1[0], bf_hi(v.z) * ri * g1[1]); o.w = cvt_pk_bf16(bf_lo(v.w) * ri * g1[2], bf_hi(v.w) * ri * g1[3]);
          *(LAS u32x4*)(VT + row * VS + c0 + 8 * j) = o; } }
    __syncthreads();
    const bf16_t* Ws = WSP(bf16_t, WS_SGW) + ((size_t)(l * 8 + g) * 128 + 16 * w + l15) * 128 + 8 * h;
    v8s bw[4];
#pragma unroll
    for (int ks = 0; ks < 4; ++ks) bw[ks] = ld16(Ws + 32 * ks);
    const int q = 16 * w + l15; const float bq = F.in[22][(size_t)l * 1024 + g * 128 + q];
#pragma unroll 2
    for (int cb = 0; cb < 8; ++cb) {
        f32x4 acc = {0.f, 0.f, 0.f, 0.f};
#pragma unroll
        for (int ks = 0; ks < 4; ++ks) {
            const int rb = 32 * ks + 8 * h + (l15 >> 2), cc = 16 * cb + 4 * (lane & 3);
            const v4s t0v = __builtin_amdgcn_ds_read_tr16_b64_v4i16((LAS v4s*)(VT + rb * VS + cc));
            const v4s t1v = __builtin_amdgcn_ds_read_tr16_b64_v4i16((LAS v4s*)(VT + (rb + 4) * VS + cc));
            const v8s a = __builtin_shufflevector(t0v, t1v, 0, 1, 2, 3, 4, 5, 6, 7);
            acc = mma_bf(a, bw[ks], acc);
        }
        const size_t rowo = (size_t)(t0 + q);
        const u32x2 uu = *(const u32x2*)(P + rowo * LDP + PU + g * 128 + 16 * cb + 4 * h);
        u32x2 o; o.x = cvt_pk_bf16(bf_lo(uu.x) * (acc[0] + bq), bf_hi(uu.x) * (acc[1] + bq)); o.y = cvt_pk_bf16(bf_lo(uu.y) * (acc[2] + bq), bf_hi(uu.y) * (acc[3] + bq));
        *(u32x2*)(Y + rowo * D + 2048 + g * 128 + 16 * cb + 4 * h) = o;
    }
}

template <int NE>
__device__ __forceinline__ void scan_elems(Frame& F, const int (&e)[NE]) {
    const bf16_t* LS = WSP(bf16_t, WS_LS); const float* TOT = WSP(float, WS_TOT); bf16_t* SE = WSP(bf16_t, WS_SE);
    int d[NE], hd[NE], pn4[NE]; f32x4 S[NE];
#pragma unroll
    for (int j = 0; j < NE; ++j) { d[j] = e[j] >> 16; hd[j] = (e[j] >> 11) & 31; pn4[j] = e[j] & 2047; S[j] = (f32x4){0.f, 0.f, 0.f, 0.f}; }
#pragma unroll 1
    for (int s0 = 0; s0 < NCHK; s0 += 5) {
        f32x4 ls[NE][5]; float dc[NE][5]; size_t off[NE][5];
#pragma unroll
        for (int j = 0; j < NE; ++j)
#pragma unroll
            for (int k = 0; k < 5; ++k) { const int step = s0 + k; const int ci = d[j] == 0 ? step : (step < 2 ? 1 - step : 131 - step);
                off[j][k] = ((size_t)(d[j] * NCHK + ci) * 32 + hd[j]) * 8192 + (size_t)pn4[j] * 4; const u32x2 lv = *(const u32x2*)(LS + off[j][k]);
                ls[j][k] = (f32x4){bf_lo(lv.x), bf_hi(lv.x), bf_lo(lv.y), bf_hi(lv.y)}; dc[j][k] = TOT[(d[j] * NCHK + ci) * 32 + hd[j]]; }
#pragma unroll
        for (int j = 0; j < NE; ++j)
#pragma unroll
            for (int k = 0; k < 5; ++k) { u32x2 o; o.x = cvt_pk_bf16(S[j][0], S[j][1]); o.y = cvt_pk_bf16(S[j][2], S[j][3]); *(u32x2*)(SE + off[j][k]) = o; S[j] = S[j] * expf(dc[j][k]) + ls[j][k]; }
    }
}
__device__ __forceinline__ void scan_phase(Frame& F, int nskip) {
    const int b = (int)blockIdx.x;
    if (F.G != 256 || nskip == 0) { for (int e = b * NTHR + F.tid; e < 131072; e += F.G * NTHR) { const int ee[1] = {e}; scan_elems<1>(F, ee); } return; }
    if (b < nskip) return;
    const int e1 = (b - nskip) * NTHR + F.tid;
    if (b < 2 * nskip) { const int ee[2] = {e1, (256 - nskip) * NTHR + (b - nskip) * NTHR + F.tid}; scan_elems<2>(F, ee); }
    else { const int ee[1] = {e1}; scan_elems<1>(F, ee); }
}

struct PF8 { u32x4 x[2], s0[2], s1[2], z[2]; };
__device__ __forceinline__ void ssd_prefetch(PF8& pf, const bf16_t* XTc, const bf16_t* SE0, const bf16_t* SE1, const bf16_t* Pz, int hd, int tid, int lane) {
#pragma unroll
    for (int j = 0; j < 2; ++j) { const int id = tid + NTHR * j, row = id >> 4, c = (id & 15) * 8;
        pf.x[j] = *(const u32x4*)(XTc + (size_t)(hd * 64 + row) * NT + c);
        pf.s0[j] = *(const u32x4*)(SE0 + ((size_t)hd * 64 + row) * 128 + c); pf.s1[j] = *(const u32x4*)(SE1 + ((size_t)hd * 64 + row) * 128 + c); }
#pragma unroll
    for (int j = 0; j < 2; ++j) { const int id = lane + 64 * j, row = id >> 3, c = (id & 7) * 8; pf.z[j] = *(const u32x4*)(Pz + (size_t)row * LDP + hd * 64 + c); }
}
__device__ __forceinline__ void ssd_commit(const PF8& pf, LAS bf16_t* XTt, LAS bf16_t* SEt, LAS bf16_t* Zw, int tid, int lane) {
#pragma unroll
    for (int j = 0; j < 2; ++j) { const int id = tid + NTHR * j, row = id >> 4, c = (id & 15) * 8;
        *(LAS u32x4*)(XTt + row * 136 + c) = pf.x[j]; *(LAS u32x4*)(SEt + row * 136 + c) = pf.s0[j]; *(LAS u32x4*)(SEt + 64 * 136 + row * 136 + c) = pf.s1[j]; }
#pragma unroll
    for (int j = 0; j < 2; ++j) { const int id = lane + 64 * j, row = id >> 3, c = (id & 7) * 8; *(LAS u32x4*)(Zw + row * 72 + c) = pf.z[j]; }
}
__device__ __forceinline__ void ssd_out_unit(Frame& F, int l, int ci, int g, const bf16_t* SE0, const bf16_t* SE1) {
    const bf16_t* XC = WSP(bf16_t, WS_XC); const bf16_t* P = WSP(bf16_t, WS_P);
    const float* CS = WSP(float, WS_CS); const float* EIN = WSP(float, WS_EIN); const float* DT = WSP(float, WS_DT); bf16_t* Y = WSP(bf16_t, WS_Y);
    LAS float* csT = (LAS float*)F.lds;
    LAS float* dtT = csT + 2048;
    LAS float* eiT = csT + 4096;
    LAS bf16_t* XTt = (LAS bf16_t*)(F.lds + 24576);
    LAS bf16_t* SEt = XTt + 64 * 136;
    LAS bf16_t* Zw = (LAS bf16_t*)(F.lds + 24576 + 3 * 17408) + F.wave * (16 * 72);
    LAS float* RS = (LAS float*)(F.lds + 24576 + 3 * 17408 + 8 * 2304) + F.wave * 16;
    const int t0 = chunk_t0(ci), w = F.wave, lane = F.lane, l15 = lane & 15, h = lane >> 4;
    const bf16_t* XTc = WSP(bf16_t, WS_XT) + t0; const bf16_t* Pz = P + (size_t)(t0 + 16 * w) * LDP + PZ;
    PF8 pf;
    ssd_prefetch(pf, XTc, SE0, SE1, Pz, g * 8, F.tid, lane);
    LDS_BAR();
    for (int i = F.tid; i < 2048; i += NTHR) { const int d = i >> 10, r = (i >> 7) & 7, s = i & 127, hd = g * 8 + r; const size_t ix = ((size_t)d * NT + t0 + s) * 32 + hd;
        csT[i] = CS[ix]; eiT[i] = EIN[ix]; dtT[i] = DT[(size_t)(t0 + s) * 64 + d * 32 + hd]; }
    ssd_commit(pf, XTt, SEt, Zw, F.tid, lane);
    ssd_prefetch(pf, XTc, SE0, SE1, Pz, g * 8 + 1, F.tid, lane);
    v8s cf[4];
#pragma unroll
    for (int ks = 0; ks < 4; ++ks) cf[ks] = ld16(XC + (size_t)(t0 + 16 * w + l15) * 3072 + 2560 + g * 128 + 32 * ks + 8 * h);
    f32x4 cbt[8];
#pragma unroll
    for (int sb = 0; sb < 8; ++sb) { cbt[sb] = (f32x4){0.f, 0.f, 0.f, 0.f};
#pragma unroll
        for (int ks = 0; ks < 4; ++ks) cbt[sb] = mma_bf(ld16(XC + (size_t)(t0 + 16 * sb + l15) * 3072 + 2048 + g * 128 + 32 * ks + 8 * h), cf[ks], cbt[sb]); }
    float ss[4] = {0.f, 0.f, 0.f, 0.f};
    const int qa = 16 * w + l15;
    const int wh = w >> 1;
#pragma unroll 1
    for (int r = 0; r < 8; ++r) {
        LDS_BAR();
        const int hd = g * 8 + r;
        const float csq0 = csT[r * 128 + qa], csq1 = csT[(8 + r) * 128 + qa];
        f32x4 acc[4];
#pragma unroll
        for (int pb = 0; pb < 4; ++pb) acc[pb] = (f32x4){0.f, 0.f, 0.f, 0.f};
#pragma unroll
        for (int ks = 0; ks < 4; ++ks) {
            v8s bx[4];
#pragma unroll
            for (int pb = 0; pb < 4; ++pb) { const LAS bf16_t* xp = XTt + (16 * pb + l15) * 136 + 32 * ks + 4 * h; const v4s lo = *(const LAS v4s*)xp, hi = *(const LAS v4s*)(xp + 16); bx[pb] = __builtin_shufflevector(lo, hi, 0, 1, 2, 3, 4, 5, 6, 7); }
#pragma unroll
            for (int d = 0; d < 2; ++d) {
                const bool active = d == 0 ? (ks <= wh) : (ks >= wh);
                if (active) {
                    float e[8];
#pragma unroll
                    for (int hf = 0; hf < 2; ++hf) { const int sb = 2 * ks + hf, sbase = 16 * sb + 4 * h;
                        const f32x4 c4 = *(const LAS f32x4*)(csT + (d * 8 + r) * 128 + sbase), d4 = *(const LAS f32x4*)(dtT + (d * 8 + r) * 128 + sbase);
#pragma unroll
                        for (int i = 0; i < 4; ++i) { const int s = sbase + i; const bool ok = d == 0 ? (qa >= s) : (qa <= s);
                            const float arg = fminf((d == 0 ? csq0 : csq1) - c4[i], 0.f);
                            e[4 * hf + i] = ok ? cbt[sb][i] * __expf(arg) * d4[i] : 0.f; } }
                    const v8s af = pack8_bf(e[0], e[1], e[2], e[3], e[4], e[5], e[6], e[7]);
#pragma unroll
                    for (int pb = 0; pb < 4; ++pb) acc[pb] = mma_bf(af, bx[pb], acc[pb]);
                }
            }
        }
#pragma unroll
        for (int d = 0; d < 2; ++d) {
            const float eq = eiT[(d * 8 + r) * 128 + qa];
#pragma unroll
            for (int ks = 0; ks < 4; ++ks) { const u32x4 raw = __builtin_bit_cast(u32x4, cf[ks]);
                const v8s a = pack8_bf(bf_lo(raw.x) * eq, bf_hi(raw.x) * eq, bf_lo(raw.y) * eq, bf_hi(raw.y) * eq, bf_lo(raw.z) * eq, bf_hi(raw.z) * eq, bf_lo(raw.w) * eq, bf_hi(raw.w) * eq);
#pragma unroll
                for (int pb = 0; pb < 4; ++pb) acc[pb] = mma_bf(a, *(const LAS v8s*)(SEt + d * (64 * 136) + (16 * pb + l15) * 136 + 32 * ks + 8 * h), acc[pb]); }
        }
        const float dsk = F.in[18][l * 32 + hd];
#pragma unroll
        for (int pb = 0; pb < 4; ++pb) {
            const u32x2 x4 = *(const LAS u32x2*)(XTt + (16 * pb + l15) * 136 + 16 * w + 4 * h);
            const float xs[4] = {bf_lo(x4.x), bf_hi(x4.x), bf_lo(x4.y), bf_hi(x4.y)};
#pragma unroll
            for (int i = 0; i < 4; ++i) { const int ql = 4 * h + i; const float z = bf1(Zw[ql * 72 + 16 * pb + l15]);
                const float y = (acc[pb][i] + dsk * xs[i]) * z; ss[i] += y * y;
                Y[(size_t)(t0 + 16 * w + ql) * D + hd * 64 + 16 * pb + l15] = f2bf(y); }
        }
        LDS_BAR();
        if (r < 7) { ssd_commit(pf, XTt, SEt, Zw, F.tid, lane); if (r < 6) ssd_prefetch(pf, XTc, SE0, SE1, Pz, g * 8 + r + 2, F.tid, lane); }
    }
#pragma unroll
    for (int i = 0; i < 4; ++i) { float v = ss[i]; v += __shfl_xor(v, 1); v += __shfl_xor(v, 2); v += __shfl_xor(v, 4); v += __shfl_xor(v, 8);
        if (l15 == 0) RS[4 * h + i] = 1.0f / sqrtf(v * (1.0f / 512.0f) + EPS); }
    asm volatile("s_waitcnt vmcnt(0) lgkmcnt(0)" ::: "memory");
    { const float* gn = F.in[19] + (size_t)l * 2048 + g * 512 + lane * 8; const f32x4 g0 = *(const f32x4*)gn, g1 = *(const f32x4*)(gn + 4);
#pragma unroll 4
      for (int k = 0; k < 16; ++k) { bf16_t* yp = Y + (size_t)(t0 + 16 * w + k) * D + g * 512 + lane * 8; const u32x4 v = *(const u32x4*)yp; const float rk = RS[k]; u32x4 o;
          o.x = cvt_pk_bf16(bf_lo(v.x) * rk * g0[0], bf_hi(v.x) * rk * g0[1]); o.y = cvt_pk_bf16(bf_lo(v.y) * rk * g0[2], bf_hi(v.y) * rk * g0[3]);
          o.z = cvt_pk_bf16(bf_lo(v.z) * rk * g1[0], bf_hi(v.z) * rk * g1[1]); o.w = cvt_pk_bf16(bf_lo(v.w) * rk * g1[2], bf_hi(v.w) * rk * g1[3]);
          *(u32x4*)yp = o; } }
}

#ifndef SKIPM
#define SKIPM 0
#endif
#ifndef REPM
#define REPM 0
#endif
#ifndef REPA
#define REPA 0
#endif
#ifndef REPB
#define REPB 0
#endif
struct Args { const float* in[32]; float* out; unsigned char* ws; int ph_lo, ph_hi; };
constexpr int N_PHASES = 2 + 14 * NL + 1;

__global__ void __launch_bounds__(NTHR, 2) trunk_fwd(Args args) {
    extern __shared__ __attribute__((aligned(16))) unsigned char lds_raw[];
    Frame F;
    F.lds = (LAS unsigned char*)lds_raw; F.ws = args.ws; F.in = args.in; F.out = args.out;
    F.tid = threadIdx.x; F.lane = F.tid & 63; F.wave = __builtin_amdgcn_readfirstlane(F.tid >> 6);
    F.G = gridDim.x; F.gw = blockIdx.x * NWAVES + F.wave; F.NGW = F.G * NWAVES;
    volatile LAS unsigned* MISC = (volatile LAS unsigned*)(F.lds + LDS_MISC);
    if (F.tid < 64) MISC[F.tid] = 0u;
    __syncthreads();
    const int lo = args.ph_lo, hi = args.ph_hi;
    XcdBarrier bar; bar.bar = WSP(unsigned, WS_CTL) + 4096; bar.x = 0; bar.st = MISC + 8;
    if (hi - lo > 1) bar = xcd_barrier_post(WSP(unsigned, WS_CTL) + 4096, MISC + 8);
    int ph = 0;
#define PHASE_BEGIN if (lo <= ph && ph < hi) { { int _t = threadIdx.x; asm volatile("" : "+v"(_t)); F.tid = _t; F.lane = _t & 63; }
#define PHASE_END if (ph + 1 < hi) xcd_barrier(bar); } ++ph;

    PHASE_BEGIN for (int rep_ = 0; rep_ < 1 + ((REPM >> 0) & 1); ++rep_) if (!((SKIPM >> 0) & 1)) { prologue_a(F); } PHASE_END
    PHASE_BEGIN for (int rep_ = 0; rep_ < 1 + ((REPM >> 1) & 1); ++rep_) if (!((SKIPM >> 1) & 1)) { prologue_b(F); } PHASE_END

    float* CTXR = WSP(float, WS_CTXR);
#pragma unroll 1
    for (int l = 0; l < NL; ++l) {
        const bool last = (l == NL - 1);
        unsigned char* wl = F.ws + WS_W + (size_t)l * LW_SIZE;
        const int Mm = last ? NX : NT;
#pragma unroll 1
        for (int h = 0; h < 2; ++h) {
            const int Mh = h ? Mm : NT;
            PHASE_BEGIN { const bool first = (l == 0 && h == 0);
                norm_phase(F, first ? F.in[0] : F.out, first ? F.in[2] : CTXR, F.out, CTXR, first ? (const bf16_t*)nullptr : WSP(bf16_t, WS_DL), (h ? F.in[27] : F.in[7]) + (size_t)l * D, l, h ? 6 : 0, Mh,
                    CtxWork{h ? !last : l > 0, h ? WSP(bf16_t, WS_MG) : WSP(bf16_t, WS_A), (const bf16_t*)(h ? wl + LW_OUT : wl - LW_SIZE + LW_2B), h ? modv(F, l, 1, 5) : modv(F, l > 0 ? l - 1 : 0, 1, 8), h ? 1.0f : 0.5f,
                            WSP(unsigned, WS_CTL) + 16384 + 64 * (l * 3 + 2 * h)}); } PHASE_END
            PHASE_BEGIN { { pg8::Gemm g{WSP(bf16_t, WS_H), (const bf16_t*)(wl + (h ? LW_13B : LW_13A)), Mh, 2 * D, D}; pg8::StaticOrder S; S.init(Mh, 2 * D, F.G, (int)blockIdx.x);
                EpiSwiGLU E{WSP(bf16_t, WS_A)}; pg8::gemm_phase<EpiSwiGLU, pg8::StaticOrder, true, true>(F.lds, g, S, E); } convert_in_tail(F, l + 1, h ? CV_MRG : CV_PRO, h ? IL_ITEMS : CV_INP, ((Mh / 256) * 32) % F.G); } PHASE_END
            PHASE_BEGIN { { pg8::Gemm g{WSP(bf16_t, WS_A), (const bf16_t*)(wl + (h ? LW_2B : LW_2A)), NX, D, D}; pg8::StaticOrder S; S.init(NX, D, F.G, (int)blockIdx.x);
                EpiDelta E{WSP(bf16_t, WS_DL), modv(F, l, 0, h ? 8 : 2), modv(F, l, 1, h ? 8 : 2), 0.5f}; pg8::gemm_phase<EpiDelta, pg8::StaticOrder, true, true>(F.lds, g, S, E); } } PHASE_END
            if (h == 0) {
            PHASE_BEGIN for (int rep_ = 0; rep_ < 1 + ((REPM >> 5) & 1); ++rep_) if (!((SKIPM >> 5) & 1)) { norm_phase(F, l == 0 ? F.in[0] : F.out, l == 0 ? F.in[2] : CTXR, F.out, CTXR, WSP(bf16_t, WS_DL), F.in[11] + (size_t)l * D, l, 3, NT,
                    CtxWork{true, WSP(bf16_t, WS_A), (const bf16_t*)(wl + LW_2A), modv(F, l, 1, 2), 0.5f, WSP(unsigned, WS_CTL) + 16384 + 64 * (l * 3 + 1)}); } PHASE_END
            PHASE_BEGIN for (int rep_ = 0; rep_ < 1 + ((REPM >> 6) & 1); ++rep_) if (!((SKIPM >> 6) & 1)) { { pg8::Gemm g{WSP(bf16_t, WS_H), (const bf16_t*)(wl + LW_IN), NT, LDP, D}; pg8::StaticOrder S; S.init(NT, LDP, F.G, (int)blockIdx.x);
                EpiProj E{WSP(bf16_t, WS_P), WSP(float, WS_DT), WSP(float, WS_BIN) + (size_t)l * LDP}; pg8::gemm_phase<EpiProj, pg8::StaticOrder, true, true>(F.lds, g, S, E); } } PHASE_END
            PHASE_BEGIN for (int rep_ = 0; rep_ < 1 + ((REPM >> 7) & 1); ++rep_) if (!((SKIPM >> 7) & 1)) {
                for (int rr = 0; rr < 1 + (REPA & 1); ++rr) conv_all(F, l);
                for (int rr = 0; rr < 1 + ((REPA >> 1) & 1); ++rr) { for (int j = F.NGW - 1 - F.gw; j < NCHK * 8; j += F.NGW) cumsum_job(F, l, j);
                for (int t = (F.NGW - 1 - F.gw) * 4; t < NT; t += F.NGW * 4) vrms_job4(F, t); }
                fft_tables_to_lds(F, WSP(bf16_t, WS_TAB + TAB_CW), WSP(bf16_t, WS_TAB + TAB_SW));
                for (int rr = 0; rr < 1 + ((REPA >> 2) & 1); ++rr) for (int u = blockIdx.x; u < 1024; u += F.G) fft1_unit(F, u >> 6, (u >> 3) & 7, u & 7);
                __syncthreads();
                { const int u = (int)blockIdx.x - (F.G - 8); if (u >= 0 && u < 8) fft1c_unit(F, u); }
            } PHASE_END
            PHASE_BEGIN for (int rep_ = 0; rep_ < 1 + ((REPM >> 8) & 1); ++rep_) if (!((SKIPM >> 8) & 1)) {
                for (int rr = 0; rr < 1 + (REPB & 1); ++rr) {
                    for (int u = blockIdx.x; u < 1024; u += F.G) ssd_local_unit4(F, 2 + (u >> 3), (u & 7) * 4);
                    for (int u = F.G - 1 - (int)blockIdx.x; u < 16; u += F.G) ssd_local_unit4(F, u >> 3, (u & 7) * 4);
                    __syncthreads(); }
                for (int rr = 0; rr < 1 + ((REPB >> 1) & 1); ++rr) for (int u = ((int)blockIdx.x + F.G - 64) % F.G; u < NCHK * 8; u += F.G) sgu_unit(F, l, u >> 3, u & 7);
                fft_tables_to_lds(F, WSP(bf16_t, WS_TAB + TAB_CW), WSP(bf16_t, WS_TAB + TAB_SWN));
                for (int rr = 0; rr < 1 + ((REPB >> 2) & 1); ++rr) for (int u = blockIdx.x; u < 1024; u += F.G) fft2_unit(F, WSP(bf16_t, WS_GPR), WSP(bf16_t, WS_GPI), u >> 3, u & 7, 0, 128, 6.905339660024878e-4f);
                for (int u = ((int)blockIdx.x + F.G - 128) % F.G; u < 16; u += F.G) fft2_unit(F, WSP(bf16_t, WS_GPC), WSP(bf16_t, WS_GPC + MiB), u >> 3, u & 7, NX, 2, 5.524271728019903e-3f);
            } PHASE_END
            PHASE_BEGIN for (int rep_ = 0; rep_ < 1 + ((REPM >> 9) & 1); ++rep_) if (!((SKIPM >> 9) & 1)) { scan_phase(F, last ? 0 : 8);
                if (!last) for (int u = blockIdx.x; u < 8; u += F.G) ssd_out_unit(F, l, u >> 2, u & 3, WSP(bf16_t, WS_SEC) + (size_t)(0 * 2 + (u >> 2)) * 32 * 8192, WSP(bf16_t, WS_SEC) + (size_t)(1 * 2 + (u >> 2)) * 32 * 8192);
                __syncthreads(); } PHASE_END
            PHASE_BEGIN for (int rep_ = 0; rep_ < 1 + ((REPM >> 10) & 1); ++rep_) if (!((SKIPM >> 10) & 1)) {
                for (int u = blockIdx.x; u < 512; u += F.G) { const int ci = 2 + (u >> 2); ssd_out_unit(F, l, ci, u & 3, WSP(bf16_t, WS_SE) + (size_t)(0 * NCHK + ci) * 32 * 8192, WSP(bf16_t, WS_SE) + (size_t)(1 * NCHK + ci) * 32 * 8192); }
                __syncthreads();
            } PHASE_END
            PHASE_BEGIN for (int rep_ = 0; rep_ < 1 + ((REPM >> 11) & 1); ++rep_) if (!((SKIPM >> 11) & 1)) { { pg8::Gemm g{WSP(bf16_t, WS_Y), (const bf16_t*)(wl + LW_BR), Mm, D, D}; pg8::StaticOrder S; S.init(Mm, D, F.G, (int)blockIdx.x);
                EpiMerge E{WSP(bf16_t, WS_P), WSP(bf16_t, WS_MG)}; pg8::gemm_phase<EpiMerge, pg8::StaticOrder, true, true>(F.lds, g, S, E); } convert_in_tail(F, l + 1, CV_INP, CV_MRG, ((Mm / 256) * 16) % F.G); } PHASE_END
            PHASE_BEGIN for (int rep_ = 0; rep_ < 1 + ((REPM >> 12) & 1); ++rep_) if (!((SKIPM >> 12) & 1)) { { pg8::Gemm g{WSP(bf16_t, WS_MG), (const bf16_t*)(wl + LW_OUT), NX, D, D}; pg8::StaticOrder S; S.init(NX, D, F.G, (int)blockIdx.x);
                EpiDelta E{WSP(bf16_t, WS_DL), modv(F, l, 0, 5), modv(F, l, 1, 5), 1.0f}; pg8::gemm_phase<EpiDelta, pg8::StaticOrder, true, true>(F.lds, g, S, E); } } PHASE_END
            }
        }
    }
    PHASE_BEGIN for (int rep_ = 0; rep_ < 1 + ((REPM >> 16) & 1); ++rep_) if (!((SKIPM >> 16) & 1)) { final_norm_phase(F, WSP(bf16_t, WS_DL), F.in[31]); } PHASE_END
#undef PHASE_BEGIN
#undef PHASE_END
}

extern "C" void kernel_launch(void* const* d_in, const int* in_sizes, int n_in, void* d_out, int out_size, void* d_ws, size_t ws_size, hipStream_t stream) {
    static int grid = 0;
    if (grid == 0) {
        if (n_in != 32 || out_size != NX * D || ws_size < WS_END) { fprintf(stderr, "kernel_launch: unexpected shapes (n_in %d, out %d, ws %zu < %zu)\n", n_in, out_size, ws_size, (size_t)WS_END); grid = -1; return; }
        int dev = 0, cus = 0;
        if (hipGetDevice(&dev) != hipSuccess || hipDeviceGetAttribute(&cus, hipDeviceAttributeMultiprocessorCount, dev) != hipSuccess) { grid = -1; return; }
        if (hipFuncSetAttribute((const void*)trunk_fwd, hipFuncAttributeMaxDynamicSharedMemorySize, LDS_BYTES) != hipSuccess) { fprintf(stderr, "kernel_launch: hipFuncSetAttribute failed\n"); grid = -1; return; }
        int per_cu = 0;
        if (hipOccupancyMaxActiveBlocksPerMultiprocessor(&per_cu, (const void*)trunk_fwd, NTHR, LDS_BYTES) != hipSuccess || per_cu < 1) { fprintf(stderr, "kernel_launch: occupancy query says %d\n", per_cu); }
        (void)hipGetLastError();
        grid = cus;
    }
    if (grid < 0) return;
    (void)in_sizes;
    hipMemsetAsync((char*)d_ws + WS_CTL, 0, MiB, stream);
    Args a{};
    for (int i = 0; i < 32; ++i) a.in[i] = (const float*)d_in[i];
    a.out = (float*)d_out; a.ws = (unsigned char*)d_ws;
#if MK_SPLIT
    for (int p = 0; p < N_PHASES; ++p) { a.ph_lo = p; a.ph_hi = p + 1; hipLaunchKernelGGL(trunk_fwd, dim3(grid), dim3(NTHR), LDS_BYTES, stream, a); }
#else
    a.ph_lo = 0; a.ph_hi = N_PHASES;
    hipLaunchKernelGGL(trunk_fwd, dim3(grid), dim3(NTHR), LDS_BYTES, stream, a);
#endif
}
```
